# Optimizing an MI355X kernel written in HIP

```python
import jax, jax.numpy as jnp
from jax import lax
import numpy as np

D_MODEL = 2048
BATCH = 1
SEQ = 16384
DEPTH = 2

N_MEM = 256
EPS = 1e-6
NEG = -1e30
POOL_WINDOWS = (2, 4, 8, 16)
POOL_GROUPS = 4
POOL_GW = D_MODEL // 8
POOL_W = POOL_GROUPS * POOL_GW
SWA_CONFIGS = ((128, 1), (512, 4), (2048, 16))
SWA_GROUPS = 3
SWA_HPG = 4
SWA_HEADS = SWA_GROUPS * SWA_HPG
HEAD_DIM = 128
SWA_QKV = SWA_HEADS * HEAD_DIM
SWA_OUT = SWA_HPG * HEAD_DIM
BLK = 128
GLA_HEADS = 4
GLA_DK = D_MODEL // 16
GLA_DV = D_MODEL // 8
GLA_K = GLA_HEADS * GLA_DK
GLA_V = GLA_HEADS * GLA_DV
GLA_RANK = 16
GLA_TAU = 16.0
GLA_CHUNK = 64
MEM_HEADS = 4
MEM_W = MEM_HEADS * HEAD_DIM
N_BRANCH = 4
IN_SPLITS = (POOL_W, POOL_W,
             SWA_QKV, SWA_QKV, SWA_QKV, SWA_OUT,
             GLA_K, GLA_K, GLA_V, GLA_V, GLA_RANK,
             MEM_W, MEM_W,
             N_BRANCH * D_MODEL)
D_IN = sum(IN_SPLITS)

kernel_name = 'hybrid_pool_dilswa_gla_mem_block'


def rms_norm(x, g):
    xf = x.astype(jnp.float32)
    y = xf * lax.rsqrt(jnp.mean(xf * xf, axis=-1, keepdims=True) + EPS)
    return (y * g.astype(jnp.float32)).astype(x.dtype)


def pool_mixer(u, gate, w_pool, scale):
    B, S, _ = u.shape
    ug = u.reshape(B, S, POOL_GROUPS, POOL_GW).astype(jnp.float32)
    cs = jnp.cumsum(ug, axis=1)
    cs0 = jnp.pad(cs, ((0, 0), (1, 0), (0, 0), (0, 0)))
    pos = jnp.arange(S)
    outs = []
    for g, w in enumerate(POOL_WINDOWS):
        hi = cs[:, :, g]
        lo = jnp.pad(cs0[:, :S - w + 1, g], ((0, 0), (w - 1, 0), (0, 0)))
        cnt = jnp.minimum(pos + 1, w).astype(jnp.float32)[None, :, None]
        outs.append((hi - lo) / cnt - ug[:, :, g])
    pooled = jnp.stack(outs, axis=2).astype(u.dtype)
    mixed = jnp.einsum('bsgc,gcd->bsgd', pooled, w_pool).reshape(B, S, POOL_W) * scale
    return mixed * jax.nn.silu(gate)


def dilated_window_attn(q, k, v, window, dilation, slopes):
    B, S, H, Dh = q.shape
    nk = window // dilation
    L = -(-S // (dilation * BLK)) * BLK
    pad = L * dilation - S
    nb = L // BLK

    def to_blocks(t):
        t = jnp.pad(t, ((0, 0), (0, pad), (0, 0), (0, 0)))
        t = t.reshape(B, L, dilation, H, Dh).transpose(0, 2, 1, 3, 4)
        return t.reshape(B, dilation, nb, BLK, H, Dh)

    def band(t):
        prev = jnp.pad(t[:, :, :-1], ((0, 0), (0, 0), (1, 0), (0, 0), (0, 0), (0, 0)))
        return jnp.concatenate([prev, t], axis=3)

    qb = to_blocks(q)
    kk = band(to_blocks(k))
    vv = band(to_blocks(v))
    s = jnp.einsum('brnqhd,brnkhd->brnhqk', qb, kk).astype(jnp.float32) * (Dh ** -0.5)
    qi = jnp.arange(BLK)[:, None]
    kj = jnp.arange(2 * BLK)[None, :] - BLK
    delta = qi - kj
    first = (jnp.arange(nb) == 0)[:, None, None]
    valid = (delta >= 0) & (delta <= nk) & ~(first & (kj < 0))
    bias = -slopes[:, None, None] * (delta * dilation).astype(jnp.float32)
    s = jnp.where(valid[None, None, :, None], s + bias[None, None, None], NEG)
    m = jnp.max(s, axis=-1, keepdims=True)
    e = jnp.exp(s - m)
    den = jnp.sum(e, axis=-1, keepdims=True)
    o = jnp.einsum('brnhqk,brnkhd->brnqhd', (e / den).astype(v.dtype), vv)
    lse = (m + jnp.log(den))[..., 0]
    o = o.reshape(B, dilation, L, H, Dh).transpose(0, 2, 1, 3, 4).reshape(B, L * dilation, H, Dh)[:, :S]
    lse = lse.transpose(0, 1, 2, 4, 3).reshape(B, dilation, L, H).transpose(0, 2, 1, 3)
    lse = lse.reshape(B, L * dilation, H)[:, :S]
    return o, lse


def swa_mixer(q, k, v, gate):
    B, S, _ = q.shape
    slopes = jnp.exp2(-8.0 * (jnp.arange(SWA_HEADS, dtype=jnp.float32) + 1.0) / SWA_HEADS)
    qg = q.reshape(B, S, SWA_GROUPS, SWA_HPG, HEAD_DIM)
    kg = k.reshape(B, S, SWA_GROUPS, SWA_HPG, HEAD_DIM)
    vg = v.reshape(B, S, SWA_GROUPS, SWA_HPG, HEAD_DIM)
    outs, lses = [], []
    for g, (w, d) in enumerate(SWA_CONFIGS):
        o_g, l_g = dilated_window_attn(qg[:, :, g], kg[:, :, g], vg[:, :, g], w, d,
                                       slopes[g * SWA_HPG:(g + 1) * SWA_HPG])
        outs.append(o_g)
        lses.append(l_g)
    o = jnp.stack(outs, axis=2)
    wts = jax.nn.softmax(jnp.stack(lses, axis=2), axis=2)
    o = jnp.sum(wts[..., None].astype(o.dtype) * o, axis=2).reshape(B, S, SWA_OUT)
    return o * jax.nn.silu(gate)


def gla_mixer(q, k, v, lr, gate, w_alpha, b_alpha, g_gla):
    B, S, _ = q.shape
    C = GLA_CHUNK
    nc = S // C
    f32 = jnp.float32
    z = (lr @ w_alpha + b_alpha).astype(f32)
    log_a = jax.nn.log_sigmoid(z) / GLA_TAU
    qc = q.astype(f32).reshape(B, nc, C, GLA_HEADS, GLA_DK) * (GLA_DK ** -0.5)
    kc = k.astype(f32).reshape(B, nc, C, GLA_HEADS, GLA_DK)
    vc = v.astype(f32).reshape(B, nc, C, GLA_HEADS, GLA_DV)
    bc = jnp.cumsum(log_a.reshape(B, nc, C, GLA_HEADS, GLA_DK), axis=2)
    b_last = bc[:, :, -1]
    q_t = qc * jnp.exp(bc)
    k_t = kc * jnp.exp(-bc)
    causal = jnp.tril(jnp.ones((C, C), dtype=bool))
    a = jnp.where(causal, jnp.einsum('bcihk,bcjhk->bchij', q_t, k_t), 0.0)
    o_intra = jnp.einsum('bchij,bcjhv->bcihv', a, vc)
    kv = jnp.einsum('bcjhk,bcjhv->bchkv', kc * jnp.exp(b_last[:, :, None] - bc), vc)
    decay = jnp.exp(b_last)

    def step(state, inp):
        dec, kv_c = inp
        return dec[..., None] * state + kv_c, state

    _, s_prev = lax.scan(step, jnp.zeros((B, GLA_HEADS, GLA_DK, GLA_DV), f32),
                         (decay.transpose(1, 0, 2, 3), kv.transpose(1, 0, 2, 3, 4)))
    s_prev = s_prev.transpose(1, 0, 2, 3, 4)
    o = o_intra + jnp.einsum('bcihk,bchkv->bcihv', q_t, s_prev)
    o = o.reshape(B, S, GLA_HEADS, GLA_DV)
    o = o * lax.rsqrt(jnp.mean(o * o, axis=-1, keepdims=True) + EPS)
    o = o.reshape(B, S, GLA_V) * g_gla.astype(f32)
    return o.astype(q.dtype) * jax.nn.silu(gate)


def mem_attn(q, gate, mem, g_mem, w_mem_kv):
    B, S, _ = q.shape
    kv = rms_norm(mem, g_mem) @ w_mem_kv
    km, vm = jnp.split(kv, 2, axis=-1)
    km = km.reshape(B, N_MEM, MEM_HEADS, HEAD_DIM)
    vm = vm.reshape(B, N_MEM, MEM_HEADS, HEAD_DIM)
    qh = q.reshape(B, S, MEM_HEADS, HEAD_DIM)
    s = jnp.einsum('bshd,bmhd->bhsm', qh, km).astype(jnp.float32) * (HEAD_DIM ** -0.5)
    p = jax.nn.softmax(s, axis=-1)
    o = jnp.einsum('bhsm,bmhd->bshd', p.astype(vm.dtype), vm).reshape(B, S, MEM_W)
    return o * jax.nn.silu(gate)


def setup_inputs(seed: int = 0) -> dict:
    key = jax.random.key(seed)
    ks = jax.random.split(key, 20)
    f32 = jnp.float32
    nrm = lambda k, shape, scale: (jax.random.normal(k, shape, f32) * scale)
    return {
        'x': nrm(ks[0], (BATCH, SEQ, D_MODEL), 1.0),
        'mem': nrm(ks[1], (BATCH, N_MEM, D_MODEL), 1.0),
        'g_pre': 1.0 + nrm(ks[2], (DEPTH, D_MODEL), 0.05),
        'g_post': 1.0 + nrm(ks[3], (DEPTH, D_MODEL), 0.05),
        'g_mem': 1.0 + nrm(ks[4], (DEPTH, D_MODEL), 0.05),
        'w_in': nrm(ks[5], (DEPTH, D_MODEL, D_IN), D_MODEL ** -0.5),
        'b_merge': nrm(ks[6], (DEPTH, N_BRANCH, D_MODEL), 0.1),
        'w_pool': nrm(ks[7], (DEPTH, POOL_GROUPS, POOL_GW, POOL_GW), POOL_GW ** -0.5),
        'pool_scale': 1.0 + nrm(ks[8], (DEPTH, POOL_W), 0.05),
        'w_alpha': nrm(ks[9], (DEPTH, GLA_RANK, GLA_K), GLA_RANK ** -0.5),
        'b_alpha': nrm(ks[10], (DEPTH, GLA_K), 0.1),
        'g_gla': 1.0 + nrm(ks[11], (DEPTH, GLA_V), 0.05),
        'w_mem_kv': nrm(ks[12], (DEPTH, D_MODEL, 2 * MEM_W), D_MODEL ** -0.5),
        'w_br_pool': nrm(ks[13], (DEPTH, POOL_W, D_MODEL), POOL_W ** -0.5),
        'w_br_swa': nrm(ks[14], (DEPTH, SWA_OUT, D_MODEL), SWA_OUT ** -0.5),
        'w_br_gla': nrm(ks[15], (DEPTH, GLA_V, D_MODEL), GLA_V ** -0.5),
        'w_br_mem': nrm(ks[16], (DEPTH, MEM_W, D_MODEL), MEM_W ** -0.5),
        'w_out': nrm(ks[17], (DEPTH, D_MODEL, D_MODEL), D_MODEL ** -0.5),
    }


def reference(x, mem, g_pre, g_post, g_mem, w_in, b_merge, w_pool, pool_scale, w_alpha, b_alpha,
              g_gla, w_mem_kv, w_br_pool, w_br_swa, w_br_gla, w_br_mem, w_out):
    B, S, _ = x.shape
    split_at = np.cumsum(IN_SPLITS)[:-1]
    for l in range(DEPTH):
        h = rms_norm(x, g_pre[l])
        proj = h @ w_in[l]
        (a_val, a_gate, sq, sk, sv, s_gate, cq, ck, cv, c_gate, c_lr,
         mq, m_gate, g_logits) = jnp.split(proj, split_at, axis=-1)
        y_a = pool_mixer(a_val, a_gate, w_pool[l], pool_scale[l])
        y_b = swa_mixer(sq, sk, sv, s_gate)
        y_c = gla_mixer(cq, ck, cv, c_lr, c_gate, w_alpha[l], b_alpha[l], g_gla[l])
        y_m = mem_attn(mq, m_gate, mem, g_mem[l], w_mem_kv[l])
        gates = jax.nn.sigmoid(g_logits.reshape(B, S, N_BRANCH, D_MODEL) + b_merge[l])
        merged = (gates[:, :, 0] * (y_a @ w_br_pool[l]) + gates[:, :, 1] * (y_b @ w_br_swa[l])
                  + gates[:, :, 2] * (y_c @ w_br_gla[l]) + gates[:, :, 3] * (y_m @ w_br_mem[l]))
        x = x + rms_norm(merged @ w_out[l], g_post[l])
    return x
```

```cpp
#include <hip/hip_runtime.h>
#include <hip/hip_cooperative_groups.h>
#include <cstdio>
#include <cstdint>
namespace cg = cooperative_groups;

#define LAS __attribute__((address_space(3)))
typedef unsigned short bf16_t;
typedef short bf16x8 __attribute__((ext_vector_type(8)));
typedef float f32x4 __attribute__((ext_vector_type(4)));
typedef unsigned u32x4 __attribute__((ext_vector_type(4)));
typedef unsigned u32x2 __attribute__((ext_vector_type(2)));
typedef float f32x2 __attribute__((ext_vector_type(2)));

constexpr int S_ = 16384, D_ = 2048, NP = 19456, DIN = 19472;
constexpr int C_AVAL = 0, C_AGATE = 1024, C_SQ = 2048, C_SK = 3584, C_SV = 5120, C_SGATE = 6656, C_CQ = 7168, C_CK = 7680,
              C_CV = 8192, C_CGATE = 9216, C_MQ = 10240, C_MGATE = 10752, C_GL = 11264;
constexpr int YW = 3072, Y_POOL = 0, Y_SWA = 1024, Y_GLA = 1536, Y_MEM = 2560;
constexpr float EPS_ = 1e-6f, NEG_ = -1e30f;

__host__ __device__ __forceinline__ constexpr size_t pj(size_t t, int c) { return (size_t)(c >> 8) * ((size_t)16384 * 256) + t * 256 + (size_t)(c & 255); }
constexpr int PRS = 256;

constexpr size_t MiB = 1ull << 20;
constexpr size_t WS_WT_IN = 0;
constexpr size_t WS_WT_BR = 76 * MiB;
constexpr size_t WS_WT_OUT = 100 * MiB;
constexpr size_t WS_WT_MEMKV = 116 * MiB;
constexpr size_t WS_WT_POOL = 124 * MiB;
constexpr size_t WS_WT_LR = 125 * MiB;
constexpr size_t WS_MEMN = 126 * MiB;
constexpr size_t WS_MEMKV = 128 * MiB;
constexpr size_t WS_CTL = 129 * MiB;
constexpr size_t CTL_BYTES = 32768;
constexpr size_t WS_LSE = 130 * MiB;
constexpr size_t WS_DEC = 131 * MiB;
constexpr size_t WS_HREG = 134 * MiB;
constexpr size_t WS_Y = 198 * MiB;
constexpr size_t WS_SWAO = 294 * MiB;
constexpr size_t WS_SP = 342 * MiB;
constexpr size_t WS_BIG = 406 * MiB;
constexpr size_t WS_PROJ = 534 * MiB;
constexpr size_t WS_BC = 1142 * MiB;
constexpr size_t WS_END = 1174 * MiB;

#ifndef PH
#define PH 0xffff
#endif
#ifndef REP
#define REP 0
#endif
#define NREP(m) ((REP & (m)) ? 2 : 1)
#define GSYNC() do { xcd_barrier(xbar); if (REP & 0x2000) xcd_barrier(xbar); } while (0)
constexpr int LDS_BYTES = 144 * 1024;
constexpr int NTHREADS = 512;

struct Params {
    const float* in[18];
    float* out;
    unsigned char* ws;
};

#define LDS_WAIT() asm volatile("s_waitcnt lgkmcnt(0)" ::: "memory")
__device__ __forceinline__ unsigned f2bf(float f) { unsigned u = __float_as_uint(f); return (u + 0x7fffu + ((u >> 16) & 1u)) >> 16; }
typedef __bf16 bf16x2_t __attribute__((ext_vector_type(2)));
__device__ __forceinline__ unsigned pk2(float lo, float hi) { const bf16x2_t v = {(__bf16)lo, (__bf16)hi}; return __builtin_bit_cast(unsigned, v); }
__device__ __forceinline__ float bf2f(bf16_t b) { return __uint_as_float(((unsigned)b) << 16); }
__device__ __forceinline__ float bflo(unsigned w) { return __uint_as_float(w << 16); }
__device__ __forceinline__ float bfhi(unsigned w) { return __uint_as_float(w & 0xffff0000u); }
__device__ __forceinline__ float sigmoidf_(float x) { return __builtin_amdgcn_rcpf(1.0f + __expf(-x)); }
__device__ __forceinline__ float siluf_(float x) { return x * sigmoidf_(x); }
__device__ __forceinline__ float wave_sum(float v) {
#pragma unroll
    for (int o = 1; o < 64; o <<= 1) v += __shfl_xor(v, o);
    return v;
}
__device__ __forceinline__ int opaque_tid() { int t = threadIdx.x; asm volatile("" : "+v"(t)); return t; }
__device__ __forceinline__ void lds_barrier() { asm volatile("s_waitcnt lgkmcnt(0)\n\ts_barrier" ::: "memory"); }
__device__ __forceinline__ f32x4 mfma16(bf16x8 a, bf16x8 b, f32x4 c) { return __builtin_amdgcn_mfma_f32_16x16x32_bf16(a, b, c, 0, 0, 0); }

constexpr int HTB = 128 * 64 * 2;
__device__ __forceinline__ int lds_byte(int r, int c) { const int st = (r >> 4) * 2 + (c >> 5), rr = r & 15, cc = c & 31, ob = rr * 64 + cc * 2; return st * 1024 + (ob ^ (((ob >> 9) & 1) << 5)); }
__device__ __forceinline__ void stage_rc(int b, int& R, int& C) { const int st = b / 1024, sb = b % 1024, swz = sb ^ (((sb >> 9) & 1) << 5); R = (st >> 1) * 16 + swz / 64; C = (st & 1) * 32 + (swz % 64) / 2; }
__device__ __forceinline__ int perm32(int rho) { const int n = rho >> 4, i = rho & 15; return 8 * (i >> 2) + 4 * n + (i & 3); }

struct GUnit { const char* A; const char* B; int nt, pm, pn, tag; };

template <class Sched, class Epi>
__device__ __forceinline__ void gemm_phase(LAS unsigned char* lds, const int lda, const int ldb, const Sched& S, const Epi& E) {
    const int tid = opaque_tid(), wid = __builtin_amdgcn_readfirstlane(tid >> 6), lane = tid & 63, wr = wid >> 2, wc = wid & 3, fr = lane & 15, fq = lane >> 4;
    unsigned voffA[2], voffB[2];
#pragma unroll
    for (int i = 0; i < 2; ++i) { int R, C; stage_rc(tid * 16 + i * 8192, R, C); const int Rb = (R & ~31) + perm32(R & 31);
        voffA[i] = (unsigned)(R * lda + C) * 2u; voffB[i] = (unsigned)(Rb * ldb + C) * 2u; }
    const size_t kstep = 128;
    const size_t hstepA = (size_t)128 * lda * 2, hstepB = (size_t)128 * ldb * 2;
    const unsigned ldsw = (unsigned)wid * 1024u;
    const int aoff = lds_byte(wr * 64 + fr, fq * 8), boff = lds_byte(wc * 32 + fr, fq * 8);
#define G_SA(b, h) (((b) * 2 + (h)) * HTB)
#define G_SB(b, h) ((4 + (b) * 2 + (h)) * HTB)
#define G_STAGE(bufoff, gbase, voff) do { _Pragma("unroll") for (int _i = 0; _i < 2; ++_i) \
        __builtin_amdgcn_global_load_lds((const unsigned*)((const char*)(gbase) + (voff)[_i]), (LAS unsigned*)(lds + (bufoff) + ldsw + _i * 8192), 16, 0, 0); } while (0)
#define G_LDA(dst, b, h) do { _Pragma("unroll") for (int m = 0; m < 4; ++m) _Pragma("unroll") for (int k = 0; k < 2; ++k) dst[m][k] = *(const LAS bf16x8*)(lds + G_SA(b, h) + aoff + m * 2048 + k * 1024); } while (0)
#define G_LDB(dst, b, h) do { _Pragma("unroll") for (int n = 0; n < 2; ++n) _Pragma("unroll") for (int k = 0; k < 2; ++k) dst[n][k] = *(const LAS bf16x8*)(lds + G_SB(b, h) + boff + n * 2048 + k * 1024); } while (0)
#define G_MMA(ai, bj, At, Bt) do { __builtin_amdgcn_s_setprio(1); _Pragma("unroll") for (int m = 0; m < 4; ++m) _Pragma("unroll") for (int n = 0; n < 2; ++n) _Pragma("unroll") for (int k = 0; k < 2; ++k) \
        acc[ai][bj][m][n] = __builtin_amdgcn_mfma_f32_16x16x32_bf16(Bt[n][k], At[m][k], acc[ai][bj][m][n], 0, 0, 0); __builtin_amdgcn_s_setprio(0); } while (0)
#define G_WAIT_V(n) asm volatile("s_waitcnt vmcnt(" #n ")" ::: "memory")
#define G_WAIT_L(n) asm volatile("s_waitcnt lgkmcnt(" #n ")" ::: "memory")
#define G_BAR __builtin_amdgcn_s_barrier()
#define G_SCHED __builtin_amdgcn_sched_barrier(0)
    GUnit cur, nxt; int ui = 0;
    if (!S.next(0, cur)) return;
    f32x4 acc[2][2][4][2];
#pragma unroll
    for (int a = 0; a < 2; ++a)
#pragma unroll
        for (int b = 0; b < 2; ++b)
#pragma unroll
            for (int m = 0; m < 4; ++m)
#pragma unroll
                for (int n = 0; n < 2; ++n) acc[a][b][m][n] = (f32x4){0.f, 0.f, 0.f, 0.f};
    bf16x8 At[4][2], B0[2][2], B1[2][2];
    const char* cA = cur.A; const char* cB = cur.B;
    G_STAGE(G_SB(0, 0), cB, voffB); G_STAGE(G_SB(0, 1), cB + hstepB, voffB); G_STAGE(G_SA(0, 0), cA, voffA); G_STAGE(G_SA(0, 1), cA + hstepA, voffA);
    if (wr == 1) G_BAR;
    G_WAIT_V(2); G_BAR;
    G_STAGE(G_SB(1, 0), cB + kstep, voffB); G_STAGE(G_SA(1, 0), cA + kstep, voffA); G_STAGE(G_SB(1, 1), cB + hstepB + kstep, voffB);
    G_WAIT_V(6); G_BAR;
    for (;;) {
        const bool has_next = S.next(ui + 1, nxt);
        const char* nA = has_next ? nxt.A : cA; const char* nB = has_next ? nxt.B : cB;
        int nt = cur.nt; asm volatile("" : "+s"(nt));
        for (int t = 0; t < nt; t += 2) {
            const bool last = (t == nt - 2);
            const char* a1 = cA + (size_t)(t + 1) * kstep;
            const char* a2 = last ? nA : cA + (size_t)(t + 2) * kstep; const char* b2 = last ? nB : cB + (size_t)(t + 2) * kstep;
            const char* a3 = a2 + kstep; const char* b3 = b2 + kstep;
            G_LDB(B0, 0, 0); G_LDB(B1, 0, 1); G_SCHED; G_LDA(At, 0, 0); G_STAGE(G_SA(1, 1), a1 + hstepA, voffA);
            G_WAIT_V(8); G_WAIT_L(0); G_BAR; G_MMA(0, 0, At, B0); G_MMA(0, 1, At, B1); G_BAR; G_SCHED;
            G_LDA(At, 0, 1); G_STAGE(G_SB(0, 0), b2, voffB); G_STAGE(G_SB(0, 1), b2 + hstepB, voffB); G_STAGE(G_SA(0, 0), a2, voffA);
            G_WAIT_V(8); G_WAIT_L(0); G_BAR; G_MMA(1, 0, At, B0); G_MMA(1, 1, At, B1); G_BAR; G_SCHED;
            G_LDB(B0, 1, 0); G_LDB(B1, 1, 1); G_SCHED; G_LDA(At, 1, 0); G_STAGE(G_SA(0, 1), a2 + hstepA, voffA);
            G_WAIT_V(8); G_WAIT_L(0); G_BAR; G_MMA(0, 0, At, B0); G_MMA(0, 1, At, B1); G_BAR; G_SCHED;
            G_LDA(At, 1, 1); G_STAGE(G_SB(1, 0), b3, voffB); G_STAGE(G_SB(1, 1), b3 + hstepB, voffB); G_STAGE(G_SA(1, 0), a3, voffA);
            G_WAIT_V(8); G_WAIT_L(0); G_BAR; G_MMA(1, 0, At, B0); G_MMA(1, 1, At, B1); G_BAR; G_SCHED;
        }
        if (wr == 0) G_BAR;
        const bool keep = E(acc, cur, wr, wc, fr, fq);
        if (!has_next) break;
        if (!keep)
#pragma unroll
        for (int a = 0; a < 2; ++a)
#pragma unroll
            for (int b = 0; b < 2; ++b)
#pragma unroll
                for (int m = 0; m < 4; ++m)
#pragma unroll
                    for (int n = 0; n < 2; ++n) acc[a][b][m][n] = (f32x4){0.f, 0.f, 0.f, 0.f};
        cur = nxt; cA = nA; cB = nB; ++ui;
        if (wr == 1) G_BAR;
    }
    G_WAIT_V(0);
    G_BAR;
#undef G_SA
#undef G_SB
#undef G_STAGE
#undef G_LDA
#undef G_LDB
#undef G_MMA
#undef G_WAIT_V
#undef G_WAIT_L
#undef G_BAR
#undef G_SCHED
}

struct SchedProj {
    const char* A; const char* B; int G, c;
    __device__ __forceinline__ bool next(int i, GUnit& u) const {
        constexpr int nM = 64, nN = 76, nwg = nM * nN, NXCD = 8, WGM = 8;
        const int L = i * G + c; if (L >= nwg) return false;
        int wgid = L; { const int q = nwg / NXCD, r = nwg % NXCD, xcd = wgid % NXCD, off = wgid / NXCD; wgid = (xcd < r ? xcd * (q + 1) : r * (q + 1) + (xcd - r) * q) + off; }
        const int nig = WGM * nN, gid = wgid / nig, fm = gid * WGM, gsz = (nM - fm) < WGM ? (nM - fm) : WGM;
        u.pm = fm + ((wgid % nig) % gsz); u.pn = (wgid % nig) / gsz;
        u.A = A + (size_t)u.pm * 256 * D_ * 2; u.B = B + (size_t)u.pn * 256 * D_ * 2; u.nt = 32;
        const int pn = u.pn;
        u.tag = (pn >= 44) ? 2 : (((pn >= 4 && pn < 8) || pn == 26 || pn == 27 || (pn >= 36 && pn < 40) || pn == 42 || pn == 43) ? 1 : 0);
        return true;
    }
};
struct SchedMemKV {
    const char* A; const char* B; int b;
    __device__ __forceinline__ bool next(int i, GUnit& u) const {
        if (i > 0 || b >= 8) return false;
        const int ly = b >> 2; u.pm = ly; u.pn = b & 3; u.tag = 0; u.nt = 32;
        u.A = A + (size_t)ly * 256 * D_ * 2; u.B = B + ((size_t)ly * 1024 + (size_t)u.pn * 256) * D_ * 2;
        return true;
    }
};
struct SchedPool {
    const char* A; const char* B; int G, vcu;
    __device__ __forceinline__ bool next(int i, GUnit& u) const {
        const int T = vcu + G * i; if (T >= 256) return false;
        u.pm = T >> 2; u.pn = T & 3; u.tag = 0; u.nt = 4;
        u.A = A + ((size_t)u.pm * 256 * 1024 + (size_t)u.pn * 256) * 2; u.B = B + (size_t)u.pn * 65536 * 2;
        return true;
    }
};
struct SchedMerge {
    const char* A; const char* B; int G, vcu;
    __device__ __forceinline__ bool next(int i, GUnit& u) const {
        const int T = vcu + G * (i >> 2); if (T >= 512) return false;
        const int br = i & 3;
        const int koff = (br == 0) ? 0 : (br == 1 ? 1024 : (br == 2 ? 1536 : 2560));
        u.pm = T >> 3; u.pn = T & 7; u.tag = br; u.nt = (br & 1) ? 8 : 16;
        u.A = A + ((size_t)u.pm * 256 * YW + koff) * 2; u.B = B + ((size_t)u.pn * 256 * YW + koff) * 2;
        return true;
    }
};
struct SchedOut {
    const char* A; const char* B; int G, vcu;
    __device__ __forceinline__ bool next(int i, GUnit& u) const {
        const int T = vcu + G * i; if (T >= 512) return false;
        u.pm = T >> 3; u.pn = T & 7; u.tag = 0; u.nt = 32;
        u.A = A + (size_t)u.pm * 256 * D_ * 2; u.B = B + (size_t)u.pn * 256 * D_ * 2;
        return true;
    }
};

struct EpiBf16 {
    bf16_t* O; int ldc; const float* bias; int rowsel;
    __device__ __forceinline__ bool operator()(f32x4 (&acc)[2][2][4][2], const GUnit& u, int wr, int wc, int fr, int fq) const {
        const int mode = u.tag;
        const int row0 = u.pm * 256 + wr * 64 + fr;
        if (mode == 2) {
            const int chn0 = (u.pn - 44) * 64 + wc * 16 + fq * 4;
            const f32x4 bb0 = *(const f32x4*)(bias + chn0), bb1 = *(const f32x4*)(bias + 2048 + chn0), bb2 = *(const f32x4*)(bias + 4096 + chn0), bb3 = *(const f32x4*)(bias + 6144 + chn0);
#pragma unroll
            for (int ai = 0; ai < 2; ++ai)
#pragma unroll
                for (int m = 0; m < 4; ++m) {
                    bf16_t* rowp = O + pj((size_t)(row0 + ai * 128 + m * 16), C_GL + chn0);
                    const f32x4 z0 = acc[ai][0][m][0] + bb0, z1 = acc[ai][0][m][1] + bb1, z2 = acc[ai][1][m][0] + bb2, z3 = acc[ai][1][m][1] + bb3;
                    f32x4 r0, r1, r2, r3;
#pragma unroll
                    for (int j = 0; j < 4; ++j) {
                        const float E0 = fminf(1.0f + __expf(-z0[j]), 1e30f), E1 = fminf(1.0f + __expf(-z1[j]), 1e30f), E2 = fminf(1.0f + __expf(-z2[j]), 1e30f), E3 = fminf(1.0f + __expf(-z3[j]), 1e30f);
                        const float i0 = __builtin_amdgcn_rcpf(E0), i1 = __builtin_amdgcn_rcpf(E1), i2 = __builtin_amdgcn_rcpf(E2), i3 = __builtin_amdgcn_rcpf(E3);
                        r0[j] = E1 * i0; r1[j] = E2 * i1; r2[j] = E3 * i2; r3[j] = i3;
                    }
                    u32x2 w;
                    w.x = pk2(r0[0], r0[1]); w.y = pk2(r0[2], r0[3]); *(u32x2*)(rowp) = w;
                    w.x = pk2(r1[0], r1[1]); w.y = pk2(r1[2], r1[3]); *(u32x2*)(rowp + 8 * (size_t)16384 * 256) = w;
                    w.x = pk2(r2[0], r2[1]); w.y = pk2(r2[2], r2[3]); *(u32x2*)(rowp + 16 * (size_t)16384 * 256) = w;
                    w.x = pk2(r3[0], r3[1]); w.y = pk2(r3[2], r3[3]); *(u32x2*)(rowp + 24 * (size_t)16384 * 256) = w;
                }
            return false;
        }
        const int col0 = u.pn * 256 + wc * 32 + 8 * fq;
#pragma unroll
        for (int bj = 0; bj < 2; ++bj)
#pragma unroll
            for (int ai = 0; ai < 2; ++ai)
#pragma unroll
                for (int m = 0; m < 4; ++m) {
                    bf16_t* rowp = O + pj((size_t)(row0 + ai * 128 + m * 16), col0 + bj * 128);
                    f32x4 v0 = acc[ai][bj][m][0], v1 = acc[ai][bj][m][1];
                    if (mode != 0) {
#pragma unroll
                        for (int j = 0; j < 4; ++j) { v0[j] = siluf_(v0[j]); v1[j] = siluf_(v1[j]); }
                    }
                    u32x4 w; w.x = pk2(v0[0], v0[1]); w.y = pk2(v0[2], v0[3]); w.z = pk2(v1[0], v1[1]); w.w = pk2(v1[2], v1[3]);
                    *(u32x4*)rowp = w;
                }
        return false;
    }
};
struct EpiPool {
    bf16_t* Y; const bf16_t* proj; const float* scale;
    __device__ __forceinline__ bool operator()(f32x4 (&acc)[2][2][4][2], const GUnit& u, int wr, int wc, int fr, int fq) const {
        const int row0 = u.pm * 256 + wr * 64 + fr, col0 = u.pn * 256 + wc * 32 + 8 * fq;
        f32x4 sc[2][2];
#pragma unroll
        for (int bj = 0; bj < 2; ++bj) { sc[bj][0] = *(const f32x4*)(scale + col0 + bj * 128); sc[bj][1] = *(const f32x4*)(scale + col0 + bj * 128 + 4); }
#pragma unroll
        for (int ai = 0; ai < 2; ++ai) {
            u32x4 g[4][2];
#pragma unroll
            for (int m = 0; m < 4; ++m)
#pragma unroll
                for (int bj = 0; bj < 2; ++bj) g[m][bj] = *(const u32x4*)(proj + pj((size_t)(row0 + ai * 128 + m * 16), C_AGATE + col0 + bj * 128));
#pragma unroll
            for (int m = 0; m < 4; ++m) {
                const size_t row = (size_t)(row0 + ai * 128 + m * 16);
#pragma unroll
                for (int bj = 0; bj < 2; ++bj) {
                    const u32x4 gg = g[m][bj];
                    const f32x4 v0 = acc[ai][bj][m][0] * sc[bj][0], v1 = acc[ai][bj][m][1] * sc[bj][1];
                    u32x4 w; w.x = pk2(v0[0] * bflo(gg.x), v0[1] * bfhi(gg.x)); w.y = pk2(v0[2] * bflo(gg.y), v0[3] * bfhi(gg.y));
                    w.z = pk2(v1[0] * bflo(gg.z), v1[1] * bfhi(gg.z)); w.w = pk2(v1[2] * bflo(gg.w), v1[3] * bfhi(gg.w));
                    *(u32x4*)(Y + row * YW + col0 + bj * 128) = w;
                }
            }
            asm volatile("" ::: "memory");
        }
        return false;
    }
};
struct EpiMerge {
    bf16_t* M; const bf16_t* proj;
    __device__ __forceinline__ bool operator()(f32x4 (&acc)[2][2][4][2], const GUnit& u, int wr, int wc, int fr, int fq) const {
        const int br = u.tag;
        const int row0 = u.pm * 256 + wr * 64 + fr, col0 = u.pn * 256 + wc * 32 + 8 * fq;
#pragma unroll
        for (int ai = 0; ai < 2; ++ai) {
            u32x4 g[4][2];
#pragma unroll
            for (int m = 0; m < 4; ++m)
#pragma unroll
                for (int bj = 0; bj < 2; ++bj) g[m][bj] = *(const u32x4*)(proj + pj((size_t)(row0 + ai * 128 + m * 16), C_GL + br * 2048 + col0 + bj * 128));
#pragma unroll
            for (int m = 0; m < 4; ++m) {
                const size_t row = (size_t)(row0 + ai * 128 + m * 16);
#pragma unroll
                for (int bj = 0; bj < 2; ++bj) {
                    const int col = col0 + bj * 128;
                    const u32x4 gg = g[m][bj];
                    f32x4 v0 = acc[ai][bj][m][0], v1 = acc[ai][bj][m][1];
                    v0[0] *= bflo(gg.x); v0[1] *= bfhi(gg.x); v0[2] *= bflo(gg.y); v0[3] *= bfhi(gg.y);
                    v1[0] *= bflo(gg.z); v1[1] *= bfhi(gg.z); v1[2] *= bflo(gg.w); v1[3] *= bfhi(gg.w);
                    if (br < 3) { acc[ai][bj][m][0] = v0; acc[ai][bj][m][1] = v1; }
                    else { u32x4 w; w.x = pk2(v0[0], v0[1]); w.y = pk2(v0[2], v0[3]); w.z = pk2(v1[0], v1[1]); w.w = pk2(v1[2], v1[3]);
                        *(u32x4*)(M + row * D_ + col) = w; }
                }
            }
            asm volatile("" ::: "memory");
        }
        return br < 3;
    }
};
struct EpiU {
    bf16_t* C;
    __device__ __forceinline__ bool operator()(f32x4 (&acc)[2][2][4][2], const GUnit& u, int wr, int wc, int fr, int fq) const {
        const int row0 = u.pm * 256 + wr * 64 + fr, col0 = u.pn * 256 + wc * 32 + 8 * fq;
#pragma unroll
        for (int ai = 0; ai < 2; ++ai)
#pragma unroll
            for (int m = 0; m < 4; ++m) {
                bf16_t* rowp = C + (size_t)(row0 + ai * 128 + m * 16) * D_ + col0;
#pragma unroll
                for (int bj = 0; bj < 2; ++bj) { const f32x4 v0 = acc[ai][bj][m][0], v1 = acc[ai][bj][m][1];
                    u32x4 w; w.x = pk2(v0[0], v0[1]); w.y = pk2(v0[2], v0[3]); w.z = pk2(v1[0], v1[1]); w.w = pk2(v1[2], v1[3]); *(u32x4*)(rowp + bj * 128) = w; }
            }
        return false;
    }
};

__device__ __forceinline__ int gate_rowmap(int g) {
    const int b = g >> 11, chn = g & 2047, q = chn >> 6, ch = chn & 63;
    return q * 256 + (b >> 1) * 128 + (ch >> 4) * 32 + ((ch >> 2) & 3) * 8 + (b & 1) * 4 + (ch & 3);
}
template <bool GMAP>
__device__ __forceinline__ void transpose_item(const float* W, int src_ld, int nvalid, bf16_t* WT, int dst_ld, int dst_k0, LAS float* scr, int kb, int nb, int lane) {
    const int k0 = 64 * kb, n0 = 64 * nb;
    const int krow = lane >> 4, nq = lane & 15, fr = lane & 15, fq = lane >> 4;
    const bool ok = (n0 + 4 * nq) < nvalid;
    const float* src = W + (size_t)(k0 + krow) * src_ld + n0 + 4 * nq;
    f32x4 v[16];
#pragma unroll
    for (int i = 0; i < 16; ++i) v[i] = ok ? *(const f32x4*)(src + (size_t)(4 * i) * src_ld) : (f32x4){0.f, 0.f, 0.f, 0.f};
    LAS unsigned char* tile = (LAS unsigned char*)scr;
#pragma unroll
    for (int i = 0; i < 16; ++i) { u32x2 w; w.x = pk2(v[i].x, v[i].y); w.y = pk2(v[i].z, v[i].w); *(LAS u32x2*)(tile + (4 * i + krow) * 160 + nq * 8) = w; }
    LDS_WAIT();
    const unsigned tb = (unsigned)(uintptr_t)tile + (unsigned)((8 * fq + (fr >> 2)) * 160 + 8 * (fr & 3));
#pragma unroll
    for (int nt = 0; nt < 4; ++nt)
#pragma unroll
        for (int kh = 0; kh < 2; ++kh) {
            u32x2 a, b;
            asm volatile("ds_read_b64_tr_b16 %0, %2\n\tds_read_b64_tr_b16 %1, %2 offset:640\n\ts_waitcnt lgkmcnt(0)" : "=&v"(a), "=&v"(b) : "v"(tb + (unsigned)(kh * 32 * 160 + nt * 32)) : "memory");
            const int n = n0 + nt * 16 + fr;
            const int drow = GMAP ? gate_rowmap(n) : n;
            if (n < nvalid) *(u32x4*)(WT + (size_t)drow * dst_ld + dst_k0 + k0 + kh * 32 + 8 * fq) = (u32x4){a.x, a.y, b.x, b.y};
        }
}
template <bool GMAP = false>
__device__ __forceinline__ void cvt_job(const float* W, int src_ld, int K, int N, bf16_t* WT, int dst_ld, int dst_k0, LAS float* scr, int gw, int NGW, int lane) {
    const int nblk = (N + 63) / 64, items = (K / 64) * nblk;
    for (int it = gw; it < items; it += NGW) transpose_item<GMAP>(W, src_ld, N, WT, dst_ld, dst_k0, scr, it / nblk, it % nblk, lane);
}
__device__ __forceinline__ void cvt_win(const Params& p, int l, LAS float* scr, int gw, int NGW, int lane) {
    const float* w = p.in[5] + (size_t)l * D_ * DIN;
    bf16_t* wt = (bf16_t*)(p.ws + WS_WT_IN);
    cvt_job(w, DIN, D_, 10240, wt, D_, 0, scr, gw, NGW, lane);
    cvt_job(w + 10256, DIN, D_, 1024, wt + (size_t)10240 * D_, D_, 0, scr, (gw + NGW / 2) % NGW, NGW, lane);
    cvt_job<true>(w + 11280, DIN, D_, 8192, wt + (size_t)C_GL * D_, D_, 0, scr, (gw + NGW / 4) % NGW, NGW, lane);
}
__device__ __forceinline__ void cvt_win_item(const Params& p, int l, LAS float* scr, int id, int lane) {
    const float* w = p.in[5] + (size_t)l * D_ * DIN;
    bf16_t* wt = (bf16_t*)(p.ws + WS_WT_IN);
    const int kb = id / 304, nbg = id % 304;
    if (nbg < 160) transpose_item<false>(w, DIN, 10240, wt, D_, 0, scr, kb, nbg, lane);
    else if (nbg < 176) transpose_item<false>(w + 10256, DIN, 1024, wt + (size_t)10240 * D_, D_, 0, scr, kb, nbg - 160, lane);
    else transpose_item<true>(w + 11280, DIN, 8192, wt + (size_t)C_GL * D_, D_, 0, scr, kb, nbg - 176, lane);
}
__device__ __forceinline__ void cvt_brout_item(const Params& p, int l, LAS float* scr, int id, int lane) {
    bf16_t* wbr = (bf16_t*)(p.ws + WS_WT_BR) + (size_t)l * D_ * YW;
    if (id < 512) transpose_item<false>(p.in[13] + (size_t)l * 1024 * D_, D_, D_, wbr, YW, 0, scr, id >> 5, id & 31, lane);
    else if (id < 768) { const int i2 = id - 512; transpose_item<false>(p.in[14] + (size_t)l * 512 * D_, D_, D_, wbr, YW, 1024, scr, i2 >> 5, i2 & 31, lane); }
    else if (id < 1280) { const int i2 = id - 768; transpose_item<false>(p.in[15] + (size_t)l * 1024 * D_, D_, D_, wbr, YW, 1536, scr, i2 >> 5, i2 & 31, lane); }
    else if (id < 1536) { const int i2 = id - 1280; transpose_item<false>(p.in[16] + (size_t)l * 512 * D_, D_, D_, wbr, YW, 2560, scr, i2 >> 5, i2 & 31, lane); }
    else { const int i2 = id - 1536; transpose_item<false>(p.in[17] + (size_t)l * D_ * D_, D_, D_, (bf16_t*)(p.ws + WS_WT_OUT) + (size_t)l * D_ * D_, D_, 0, scr, i2 >> 5, i2 & 31, lane); }
}
__device__ __forceinline__ void norm_row_store(const f32x4 (&v)[8], const float* g, bf16_t* orow, int lane) {
    float ss = 0.f;
#pragma unroll
    for (int j = 0; j < 8; ++j) ss += (v[j].x * v[j].x + v[j].y * v[j].y) + (v[j].z * v[j].z + v[j].w * v[j].w);
    ss = wave_sum(ss);
    const float rs = rsqrtf(ss * (1.0f / D_) + EPS_);
    u32x2* o8 = (u32x2*)orow + lane;
#pragma unroll
    for (int j = 0; j < 8; ++j) { const f32x4 gg = *((const f32x4*)g + lane + 64 * j);
        u32x2 w; w.x = pk2(v[j].x * rs * gg.x, v[j].y * rs * gg.y); w.y = pk2(v[j].z * rs * gg.z, v[j].w * rs * gg.w); o8[64 * j] = w; }
}

__device__ __forceinline__ void phase_rows(const Params& p, LAS unsigned char* lds, int stage) {
    const int tid = opaque_tid(), lane = tid & 63, wave = tid >> 6;
    const int gw = blockIdx.x * 8 + wave, NGW = gridDim.x * 8;
    LAS float* scr = (LAS float*)(lds + wave * 10240);
    if (stage == 0) {
        cvt_win(p, 0, scr, gw, NGW, lane);
        int rot = 0;
#pragma unroll 1
        for (int l = 0; l < 2; ++l) {
            cvt_job(p.in[5] + (size_t)l * D_ * DIN + 10240, DIN, D_, 16, (bf16_t*)(p.ws + WS_WT_LR) + (size_t)l * 16 * D_, D_, 0, scr, (gw + rot) % NGW, NGW, lane); rot += 64;
#pragma unroll 1
            for (int g = 0; g < 4; ++g) { cvt_job(p.in[7] + (size_t)(l * 4 + g) * 65536, 256, 256, 256, (bf16_t*)(p.ws + WS_WT_POOL) + (size_t)(l * 4 + g) * 65536, 256, 0, scr, (gw + rot) % NGW, NGW, lane); rot += 32; }
            cvt_job(p.in[12] + (size_t)l * D_ * 1024, 1024, D_, 1024, (bf16_t*)(p.ws + WS_WT_MEMKV) + (size_t)l * 1024 * D_, D_, 0, scr, (gw + rot) % NGW, NGW, lane); rot += 1024;
            continue;
            bf16_t* wbr = (bf16_t*)(p.ws + WS_WT_BR) + (size_t)l * D_ * YW;
            cvt_job(p.in[13] + (size_t)l * 1024 * D_, D_, 1024, D_, wbr, YW, 0, scr, (gw + rot) % NGW, NGW, lane); rot += 1024;
            cvt_job(p.in[14] + (size_t)l * 512 * D_, D_, 512, D_, wbr, YW, 1024, scr, (gw + rot) % NGW, NGW, lane); rot += 512;
            cvt_job(p.in[15] + (size_t)l * 1024 * D_, D_, 1024, D_, wbr, YW, 1536, scr, (gw + rot) % NGW, NGW, lane); rot += 1024;
            cvt_job(p.in[16] + (size_t)l * 512 * D_, D_, 512, D_, wbr, YW, 2560, scr, (gw + rot) % NGW, NGW, lane); rot += 512;
            cvt_job(p.in[17] + (size_t)l * D_ * D_, D_, D_, D_, (bf16_t*)(p.ws + WS_WT_OUT) + (size_t)l * D_ * D_, D_, 0, scr, (gw + rot) % NGW, NGW, lane);
        }
        for (int r = gw; r < 512; r += NGW) {
            const int l = r >> 8, m = r & 255;
            const f32x4* xr = (const f32x4*)(p.in[1] + (size_t)m * D_) + lane;
            f32x4 v[8];
#pragma unroll
            for (int j = 0; j < 8; ++j) v[j] = xr[64 * j];
            norm_row_store(v, p.in[4] + (size_t)l * D_, (bf16_t*)(p.ws + WS_MEMN) + (size_t)r * D_, lane);
        }
    }
    const bf16_t* U = (const bf16_t*)(p.ws + WS_BIG);
    bf16_t* H = (bf16_t*)(p.ws + WS_HREG);
    const float* xsrc = p.in[0];
    bf16_t* X1B = (bf16_t*)(p.ws + WS_BIG + 64 * MiB);
    f32x4 gpost[8], gpre[8];
#pragma unroll
    for (int j = 0; j < 8; ++j) { gpost[j] = (stage >= 1) ? *((const f32x4*)(p.in[3] + (size_t)(stage - 1) * D_) + lane + 64 * j) : (f32x4){0.f, 0.f, 0.f, 0.f};
        gpre[j] = (stage < 2) ? *((const f32x4*)(p.in[2] + (size_t)(stage == 0 ? 0 : 1) * D_) + lane + 64 * j) : (f32x4){0.f, 0.f, 0.f, 0.f}; }
    u32x2 ua[8], ub[8]; f32x4 xa[8], xb[8];
#define ROW_LOAD(U_, X_, r_) do { const f32x4* xr_ = (const f32x4*)(xsrc + (size_t)(r_) * D_) + lane; const u32x2* ur_ = (const u32x2*)(U + (size_t)(r_) * D_) + lane; \
        const u32x2* xb_ = (const u32x2*)(X1B + (size_t)(r_) * D_) + lane; \
        _Pragma("unroll") for (int j = 0; j < 8; ++j) { if (stage == 2) { const u32x2 w_ = xb_[64 * j]; X_[j] = (f32x4){bflo(w_.x), bfhi(w_.x), bflo(w_.y), bfhi(w_.y)}; } else X_[j] = xr_[64 * j]; \
            U_[j] = (stage >= 1) ? ur_[64 * j] : (u32x2){0u, 0u}; } } while (0)
#define ROW_PROC(U_, X_, r_) do { f32x4 v[8]; \
        if (stage == 0) { _Pragma("unroll") for (int j = 0; j < 8; ++j) v[j] = X_[j]; } \
        else { f32x4 uu[8]; float ss = 0.f; \
            _Pragma("unroll") for (int j = 0; j < 8; ++j) { uu[j] = (f32x4){bflo(U_[j].x), bfhi(U_[j].x), bflo(U_[j].y), bfhi(U_[j].y)}; ss += (uu[j].x * uu[j].x + uu[j].y * uu[j].y) + (uu[j].z * uu[j].z + uu[j].w * uu[j].w); } \
            ss = wave_sum(ss); const float rs = rsqrtf(ss * (1.0f / D_) + EPS_); \
            f32x4* orow = (f32x4*)(p.out + (size_t)(r_) * D_) + lane; u32x2* xrow = (u32x2*)(X1B + (size_t)(r_) * D_) + lane; \
            _Pragma("unroll") for (int j = 0; j < 8; ++j) { v[j] = X_[j] + uu[j] * rs * gpost[j]; \
                if (stage == 2) orow[64 * j] = v[j]; else { u32x2 w_; w_.x = pk2(v[j].x, v[j].y); w_.y = pk2(v[j].z, v[j].w); xrow[64 * j] = w_; } } } \
        if (stage < 2) { float s2 = 0.f; \
            _Pragma("unroll") for (int j = 0; j < 8; ++j) s2 += (v[j].x * v[j].x + v[j].y * v[j].y) + (v[j].z * v[j].z + v[j].w * v[j].w); \
            s2 = wave_sum(s2); const float r2 = rsqrtf(s2 * (1.0f / D_) + EPS_); \
            u32x2* o8 = (u32x2*)(H + (size_t)(r_) * D_) + lane; \
            _Pragma("unroll") for (int j = 0; j < 8; ++j) { const f32x4 hv = v[j] * r2 * gpre[j]; u32x2 w; w.x = pk2(hv.x, hv.y); w.y = pk2(hv.z, hv.w); o8[64 * j] = w; } } } while (0)
    int row = gw;
    if (row < S_) ROW_LOAD(ua, xa, row);
    while (row < S_) {
        const int n1 = row + NGW;
        if (n1 < S_) ROW_LOAD(ub, xb, n1);
        ROW_PROC(ua, xa, row);
        if (n1 >= S_) break;
        const int n2 = n1 + NGW;
        if (n2 < S_) ROW_LOAD(ua, xa, n2);
        ROW_PROC(ub, xb, n1);
        row = n2;
    }
#undef ROW_LOAD
#undef ROW_PROC
}

__device__ __forceinline__ float logsigmoidf_(float z) { return fminf(z, 0.f) - __logf(1.0f + __expf(-fabsf(z))); }
__device__ __forceinline__ void lr_gemm(const Params& p, LAS unsigned char* lds, int l) {
    const int tid = opaque_tid(), lane = tid & 63, wid = tid >> 6, fr = lane & 15, fq = lane >> 4;
    const bf16_t* H = (const bf16_t*)(p.ws + WS_HREG);
    const bf16_t* WL = (const bf16_t*)(p.ws + WS_WT_LR) + (size_t)l * 16 * D_;
    float* BC = (float*)(p.ws + WS_BC);
    LAS float* sRed = (LAS float*)lds;
    LAS float* sLR = (LAS float*)(lds + 8192);
    for (int tb = blockIdx.x; tb < 256; tb += gridDim.x) {
        lds_barrier();
        const int mt = wid & 3, kh = wid >> 2;
        const bf16_t* hrow = H + (size_t)(tb * 64 + mt * 16 + fr) * D_ + kh * 1024 + fq * 8;
        const bf16_t* wrow = WL + (size_t)fr * D_ + kh * 1024 + fq * 8;
        f32x4 acc = (f32x4){0.f, 0.f, 0.f, 0.f};
#pragma unroll 8
        for (int ks = 0; ks < 32; ++ks) { const bf16x8 a = *(const bf16x8*)(hrow + ks * 32); const bf16x8 b = *(const bf16x8*)(wrow + ks * 32); acc = mfma16(a, b, acc); }
#pragma unroll
        for (int j = 0; j < 4; ++j) sRed[(kh * 64 + mt * 16 + fq * 4 + j) * 16 + fr] = acc[j];
        float wa[16];
#pragma unroll
        for (int r = 0; r < 16; ++r) wa[r] = p.in[9][(size_t)(l * 16 + r) * 512 + tid];
        const float b = p.in[10][l * 512 + tid];
        lds_barrier();
        for (int i = tid; i < 1024; i += NTHREADS) sLR[i] = sRed[i] + sRed[1024 + i];
        lds_barrier();
        float run = 0.f;
        float* bcp = BC + (size_t)tb * 64 * 512 + tid;
#pragma unroll 4
        for (int j = 0; j < 64; ++j) { float z = b;
#pragma unroll
            for (int r4 = 0; r4 < 4; ++r4) { const f32x4 v = *(const LAS f32x4*)(sLR + j * 16 + r4 * 4); z += v.x * wa[r4 * 4] + v.y * wa[r4 * 4 + 1] + v.z * wa[r4 * 4 + 2] + v.w * wa[r4 * 4 + 3]; }
            run += logsigmoidf_(z) * (1.0f / 16.0f); bcp[(size_t)j * 512] = run; }
    }
}

__device__ __forceinline__ bf16x8 cat_frag(u32x2 lo, u32x2 hi) { const u32x4 w = (u32x4){lo.x, lo.y, hi.x, hi.y}; return __builtin_bit_cast(bf16x8, w); }
template <int HALF>
__device__ __forceinline__ bf16x8 tr2(unsigned vb) {
    u32x2 a, b;
    asm volatile("ds_read_b64_tr_b16 %0, %2\n\tds_read_b64_tr_b16 %1, %2 offset:%3\n\ts_waitcnt lgkmcnt(0)" : "=&v"(a), "=&v"(b) : "v"(vb), "i"(HALF) : "memory");
    return cat_frag(a, b);
}
template <int HALF>
__device__ __forceinline__ void tr16(unsigned vb, u32x2 (&r)[16]) {
    asm volatile(
        "ds_read_b64_tr_b16 %0, %16 offset:%17\n\tds_read_b64_tr_b16 %1, %16 offset:%18\n\t"
        "ds_read_b64_tr_b16 %2, %16 offset:%19\n\tds_read_b64_tr_b16 %3, %16 offset:%20\n\t"
        "ds_read_b64_tr_b16 %4, %16 offset:%21\n\tds_read_b64_tr_b16 %5, %16 offset:%22\n\t"
        "ds_read_b64_tr_b16 %6, %16 offset:%23\n\tds_read_b64_tr_b16 %7, %16 offset:%24\n\t"
        "ds_read_b64_tr_b16 %8, %16 offset:%25\n\tds_read_b64_tr_b16 %9, %16 offset:%26\n\t"
        "ds_read_b64_tr_b16 %10, %16 offset:%27\n\tds_read_b64_tr_b16 %11, %16 offset:%28\n\t"
        "ds_read_b64_tr_b16 %12, %16 offset:%29\n\tds_read_b64_tr_b16 %13, %16 offset:%30\n\t"
        "ds_read_b64_tr_b16 %14, %16 offset:%31\n\tds_read_b64_tr_b16 %15, %16 offset:%32\n\t"
        "s_waitcnt lgkmcnt(0)"
        : "=&v"(r[0]), "=&v"(r[1]), "=&v"(r[2]), "=&v"(r[3]), "=&v"(r[4]), "=&v"(r[5]), "=&v"(r[6]), "=&v"(r[7]),
          "=&v"(r[8]), "=&v"(r[9]), "=&v"(r[10]), "=&v"(r[11]), "=&v"(r[12]), "=&v"(r[13]), "=&v"(r[14]), "=&v"(r[15])
        : "v"(vb), "i"(0), "i"(HALF), "i"(32), "i"(HALF + 32), "i"(64), "i"(HALF + 64), "i"(96), "i"(HALF + 96),
          "i"(128), "i"(HALF + 128), "i"(160), "i"(HALF + 160), "i"(192), "i"(HALF + 192), "i"(224), "i"(HALF + 224)
        : "memory");
}

template <int MODE, int NT>
__device__ __forceinline__ void attn_item(LAS unsigned char* lds, const bf16_t* qbase, size_t qrs, const bf16_t* kbase, const bf16_t* vbase, size_t krs, bool first,
                                          float slope_dil, bf16_t* obase, size_t ors, const bf16_t* gbase, size_t grs, float* lsebase, size_t lrs) {
    const int tid = opaque_tid(), lane = tid & 63, wid = tid >> 6, fr = lane & 15, fq = lane >> 4;
    LAS bf16_t* sK = (LAS bf16_t*)lds;
    LAS bf16_t* sV = (LAS bf16_t*)(lds + 69632);
    lds_barrier();
#pragma unroll
    for (int i = 0; i < 8; ++i) { const int id = tid + 512 * i, row = id >> 4, ch = id & 15;
        u32x4 kv = (u32x4){0u, 0u, 0u, 0u}, vv = (u32x4){0u, 0u, 0u, 0u};
        if (!(first && row < 128)) { kv = *(const u32x4*)(kbase + (ptrdiff_t)row * (ptrdiff_t)krs + ch * 8); vv = *(const u32x4*)(vbase + (ptrdiff_t)row * (ptrdiff_t)krs + ch * 8); }
        *(LAS u32x4*)(sK + row * 136 + ch * 8) = kv; *(LAS u32x4*)(sV + row * 144 + ch * 8) = vv; }
    bf16x8 qf[4];
    { const bf16_t* qrow = qbase + (size_t)(16 * wid + fr) * qrs + fq * 8;
#pragma unroll
      for (int kk = 0; kk < 4; ++kk) qf[kk] = *(const bf16x8*)(qrow + kk * 32); }
    lds_barrier();
    const int T_lo = (NT == 16) ? 0 : 2 * (wid >> 1);
    f32x4 s[NT];
#pragma unroll
    for (int ti = 0; ti < NT; ++ti) { s[ti] = (f32x4){0.f, 0.f, 0.f, 0.f};
#pragma unroll
        for (int kk = 0; kk < 4; ++kk) { const bf16x8 kf = *(const LAS bf16x8*)(sK + ((T_lo + ti) * 16 + fr) * 136 + kk * 32 + fq * 8); s[ti] = mfma16(kf, qf[kk], s[ti]); } }
    const float scale2 = 0.08838834764831845f * 1.4426950408889634f;
    const float slope2 = slope_dil * 1.4426950408889634f;
    const int qi = 16 * wid + fr;
    const int dbase = qi + 128 - T_lo * 16 - 4 * fq;
    const float cb = -slope2 * (float)dbase;
    const int kmin = first ? 128 - T_lo * 16 - 4 * fq : -1000;
    float mx = -3.0e38f;
#pragma unroll
    for (int ti = 0; ti < NT; ++ti)
#pragma unroll
        for (int j = 0; j < 4; ++j) {
            float v;
            if (MODE == 1) { const int off = 16 * ti + j;
                const bool valid = ((unsigned)(dbase - off) <= 128u) && (off >= kmin);
                v = valid ? fmaf(s[ti][j], scale2, fmaf(slope2, (float)off, cb)) : NEG_; }
            else v = s[ti][j] * scale2;
            s[ti][j] = v; mx = fmaxf(mx, v);
        }
    mx = fmaxf(mx, __shfl_xor(mx, 16)); mx = fmaxf(mx, __shfl_xor(mx, 32));
    float sm = 0.f;
#pragma unroll
    for (int ti = 0; ti < NT; ++ti)
#pragma unroll
        for (int j = 0; j < 4; ++j) { const float e = __builtin_amdgcn_exp2f(s[ti][j] - mx); s[ti][j] = e; sm += e; }
    sm += __shfl_xor(sm, 16); sm += __shfl_xor(sm, 32);
    const float inv = 1.0f / sm;
    bf16x8 pf[NT / 2];
#pragma unroll
    for (int ks = 0; ks < NT / 2; ++ks) { u32x4 w; w.x = pk2(s[2 * ks][0] * inv, s[2 * ks][1] * inv); w.y = pk2(s[2 * ks][2] * inv, s[2 * ks][3] * inv);
        w.z = pk2(s[2 * ks + 1][0] * inv, s[2 * ks + 1][1] * inv); w.w = pk2(s[2 * ks + 1][2] * inv, s[2 * ks + 1][3] * inv); pf[ks] = __builtin_bit_cast(bf16x8, w); }
    f32x4 o[8];
#pragma unroll
    for (int dt = 0; dt < 8; ++dt) o[dt] = (f32x4){0.f, 0.f, 0.f, 0.f};
    const unsigned vb0 = (unsigned)(uintptr_t)sV + (unsigned)(((T_lo * 16 + 4 * fq + (fr >> 2)) * 144 + 4 * (fr & 3)) * 2);
#pragma unroll
    for (int ks = 0; ks < NT / 2; ++ks) {
        u32x2 r[16];
        const unsigned vb = vb0 + (unsigned)(ks * 9216);
        tr16<4608>(vb, r);
#pragma unroll
        for (int dt = 0; dt < 8; ++dt) o[dt] = mfma16(cat_frag(r[2 * dt], r[2 * dt + 1]), pf[ks], o[dt]);
    }
    const size_t i = (size_t)qi;
#pragma unroll
    for (int dt = 0; dt < 8; ++dt) { const int d = dt * 16 + 4 * fq; f32x4 val = o[dt];
        if (MODE == 0) { const u32x2 g = *(const u32x2*)(gbase + i * grs + d); val[0] *= bflo(g.x); val[1] *= bfhi(g.x); val[2] *= bflo(g.y); val[3] *= bfhi(g.y); }
        u32x2 w; w.x = pk2(val[0], val[1]); w.y = pk2(val[2], val[3]); *(u32x2*)(obase + i * ors + d) = w; }
    if (MODE == 1) { if (fq == 0) lsebase[i * lrs] = (mx + __builtin_amdgcn_logf(sm)) * 0.6931471805599453f; }
}

__device__ __forceinline__ void gla_kv_item(const Params& p, LAS unsigned char* lds, int l, int item) {
    const int tid = opaque_tid(), lane = tid & 63, wid = tid >> 6, fr = lane & 15, fq = lane >> 4;
    const int c = item >> 2, h = item & 3;
    LAS bf16_t* sKs = (LAS bf16_t*)lds;
    LAS bf16_t* sV = (LAS bf16_t*)(lds + 18432);
    const bf16_t* prow = (const bf16_t*)(p.ws + WS_PROJ) + (size_t)(c * 64) * PRS;
    const float* bcc = (const float*)(p.ws + WS_BC) + (size_t)(c * 64) * 512 + h * 128;
    lds_barrier();
#pragma unroll
    for (int i = 0; i < 2; ++i) { const int id = tid + 512 * i, j = id >> 4, ch = id & 15;
        const u32x4 kv = *(const u32x4*)(prow + pj((size_t)j, C_CK + h * 128 + ch * 8));
        const f32x4 b0 = *(const f32x4*)(bcc + (size_t)j * 512 + ch * 8), b1 = *(const f32x4*)(bcc + (size_t)j * 512 + ch * 8 + 4);
        const f32x4 l0 = *(const f32x4*)(bcc + (size_t)63 * 512 + ch * 8), l1 = *(const f32x4*)(bcc + (size_t)63 * 512 + ch * 8 + 4);
        u32x4 o;
        o.x = pk2(bflo(kv.x) * __expf(l0.x - b0.x), bfhi(kv.x) * __expf(l0.y - b0.y)); o.y = pk2(bflo(kv.y) * __expf(l0.z - b0.z), bfhi(kv.y) * __expf(l0.w - b0.w));
        o.z = pk2(bflo(kv.z) * __expf(l1.x - b1.x), bfhi(kv.z) * __expf(l1.y - b1.y)); o.w = pk2(bflo(kv.w) * __expf(l1.z - b1.z), bfhi(kv.w) * __expf(l1.w - b1.w));
        *(LAS u32x4*)(sKs + j * 144 + ch * 8) = o; }
#pragma unroll
    for (int i = 0; i < 4; ++i) { const int id = tid + 512 * i, j = id >> 5, ch = id & 31;
        *(LAS u32x4*)(sV + j * 272 + ch * 8) = *(const u32x4*)(prow + pj((size_t)j, C_CV + h * 256 + ch * 8)); }
    if (tid < 128) ((float*)(p.ws + WS_DEC))[(size_t)item * 128 + tid] = __expf(bcc[(size_t)63 * 512 + tid]);
    lds_barrier();
    f32x4 acc[8][2];
#pragma unroll
    for (int m = 0; m < 8; ++m) { acc[m][0] = (f32x4){0.f, 0.f, 0.f, 0.f}; acc[m][1] = (f32x4){0.f, 0.f, 0.f, 0.f}; }
    const unsigned kb0 = (unsigned)(uintptr_t)sKs + (unsigned)(((4 * fq + (fr >> 2)) * 144 + 4 * (fr & 3)) * 2);
    const unsigned vb0 = (unsigned)(uintptr_t)sV + (unsigned)(((4 * fq + (fr >> 2)) * 272 + 4 * (fr & 3)) * 2) + (unsigned)(wid * 64);
#pragma unroll
    for (int ks = 0; ks < 2; ++ks) {
        u32x2 r[16];
        tr16<4608>(kb0 + (unsigned)(ks * 32 * 288), r);
        const bf16x8 v0 = tr2<8704>(vb0 + (unsigned)(ks * 32 * 544)), v1 = tr2<8704>(vb0 + (unsigned)(ks * 32 * 544) + 32u);
#pragma unroll
        for (int m = 0; m < 8; ++m) { const bf16x8 kf = cat_frag(r[2 * m], r[2 * m + 1]); acc[m][0] = mfma16(kf, v0, acc[m][0]); acc[m][1] = mfma16(kf, v1, acc[m][1]); }
    }
    bf16_t* KV = (bf16_t*)(p.ws + WS_BIG) + (size_t)item * 32768;
#pragma unroll
    for (int n = 0; n < 2; ++n)
#pragma unroll
        for (int m = 0; m < 8; ++m) { u32x2 w; w.x = pk2(acc[m][n][0], acc[m][n][1]); w.y = pk2(acc[m][n][2], acc[m][n][3]);
            *(u32x2*)(KV + (size_t)((2 * wid + n) * 16 + fr) * 128 + m * 16 + 4 * fq) = w; }
}
__device__ __forceinline__ void gla_out_item(const Params& p, LAS unsigned char* lds, int l, int item) {
    const int tid = opaque_tid(), lane = tid & 63, wid = tid >> 6, fr = lane & 15, fq = lane >> 4;
    const int c = item >> 2, h = item & 3;
    LAS bf16_t* sQ = (LAS bf16_t*)lds;
    LAS bf16_t* sK2 = (LAS bf16_t*)(lds + 17408);
    LAS bf16_t* sV = (LAS bf16_t*)(lds + 34816);
    LAS float* sSS = (LAS float*)(lds + 69632);
    const bf16_t* PROJ = (const bf16_t*)(p.ws + WS_PROJ);
    const bf16_t* prow = PROJ + (size_t)(c * 64) * PRS;
    const float* bcc = (const float*)(p.ws + WS_BC) + (size_t)(c * 64) * 512 + h * 128;
    lds_barrier();
#pragma unroll
    for (int i = 0; i < 2; ++i) { const int id = tid + 512 * i, row = id >> 4, ch = id & 15;
        const u32x4 q8 = *(const u32x4*)(prow + pj((size_t)row, C_CQ + h * 128 + ch * 8));
        const u32x4 k8 = *(const u32x4*)(prow + pj((size_t)row, C_CK + h * 128 + ch * 8));
        const f32x4 b0 = *(const f32x4*)(bcc + (size_t)row * 512 + ch * 8), b1 = *(const f32x4*)(bcc + (size_t)row * 512 + ch * 8 + 4);
        const float sc = 0.08838834764831845f;
        u32x4 qo, ko;
        qo.x = pk2(bflo(q8.x) * sc * __expf(b0.x), bfhi(q8.x) * sc * __expf(b0.y)); qo.y = pk2(bflo(q8.y) * sc * __expf(b0.z), bfhi(q8.y) * sc * __expf(b0.w));
        qo.z = pk2(bflo(q8.z) * sc * __expf(b1.x), bfhi(q8.z) * sc * __expf(b1.y)); qo.w = pk2(bflo(q8.w) * sc * __expf(b1.z), bfhi(q8.w) * sc * __expf(b1.w));
        ko.x = pk2(bflo(k8.x) * __expf(-b0.x), bfhi(k8.x) * __expf(-b0.y)); ko.y = pk2(bflo(k8.y) * __expf(-b0.z), bfhi(k8.y) * __expf(-b0.w));
        ko.z = pk2(bflo(k8.z) * __expf(-b1.x), bfhi(k8.z) * __expf(-b1.y)); ko.w = pk2(bflo(k8.w) * __expf(-b1.z), bfhi(k8.w) * __expf(-b1.w));
        *(LAS u32x4*)(sQ + row * 136 + ch * 8) = qo; *(LAS u32x4*)(sK2 + row * 136 + ch * 8) = ko; }
#pragma unroll
    for (int i = 0; i < 4; ++i) { const int id = tid + 512 * i, j = id >> 5, ch = id & 31;
        *(LAS u32x4*)(sV + j * 272 + ch * 8) = *(const u32x4*)(prow + pj((size_t)j, C_CV + h * 256 + ch * 8)); }
    lds_barrier();
    const int it = wid & 3, nh = wid >> 2;
    bf16x8 qf[4];
#pragma unroll
    for (int kk = 0; kk < 4; ++kk) qf[kk] = *(const LAS bf16x8*)(sQ + (it * 16 + fr) * 136 + kk * 32 + fq * 8);
    bf16x8 pa[2];
    {
        f32x4 at[4];
#pragma unroll
        for (int jt = 0; jt < 4; ++jt) { at[jt] = (f32x4){0.f, 0.f, 0.f, 0.f};
#pragma unroll
            for (int kk = 0; kk < 4; ++kk) { const bf16x8 kf = *(const LAS bf16x8*)(sK2 + (jt * 16 + fr) * 136 + kk * 32 + fq * 8); at[jt] = mfma16(kf, qf[kk], at[jt]); }
#pragma unroll
            for (int jj = 0; jj < 4; ++jj) { const int j = jt * 16 + 4 * fq + jj, i = it * 16 + fr; at[jt][jj] = (j <= i) ? at[jt][jj] : 0.f; } }
#pragma unroll
        for (int ks = 0; ks < 2; ++ks) { u32x4 w; w.x = pk2(at[2 * ks][0], at[2 * ks][1]); w.y = pk2(at[2 * ks][2], at[2 * ks][3]);
            w.z = pk2(at[2 * ks + 1][0], at[2 * ks + 1][1]); w.w = pk2(at[2 * ks + 1][2], at[2 * ks + 1][3]); pa[ks] = __builtin_bit_cast(bf16x8, w); }
    }
    f32x4 o[8];
#pragma unroll
    for (int n8 = 0; n8 < 8; ++n8) o[n8] = (f32x4){0.f, 0.f, 0.f, 0.f};
    const unsigned vb0 = (unsigned)(uintptr_t)sV + (unsigned)(((4 * fq + (fr >> 2)) * 272 + 4 * (fr & 3)) * 2) + (unsigned)(nh * 256);
#pragma unroll
    for (int ks = 0; ks < 2; ++ks) {
        u32x2 r[16];
        tr16<8704>(vb0 + (unsigned)(ks * 32 * 544), r);
#pragma unroll
        for (int n8 = 0; n8 < 8; ++n8) o[n8] = mfma16(cat_frag(r[2 * n8], r[2 * n8 + 1]), pa[ks], o[n8]);
    }
    {
        const bf16_t* sp = (const bf16_t*)(p.ws + WS_SP) + (size_t)item * 32768 + (size_t)((nh * 8) * 16 + fr) * 128 + fq * 8;
#pragma unroll
        for (int n8 = 0; n8 < 8; ++n8)
#pragma unroll
            for (int kk = 0; kk < 4; ++kk) { const bf16x8 sf = *(const bf16x8*)(sp + (size_t)n8 * 16 * 128 + kk * 32); o[n8] = mfma16(sf, qf[kk], o[n8]); }
    }
    float a = 0.f;
#pragma unroll
    for (int n8 = 0; n8 < 8; ++n8) a += (o[n8][0] * o[n8][0] + o[n8][1] * o[n8][1]) + (o[n8][2] * o[n8][2] + o[n8][3] * o[n8][3]);
    a += __shfl_xor(a, 16); a += __shfl_xor(a, 32);
    if (fq == 0) sSS[nh * 64 + it * 16 + fr] = a;
    lds_barrier();
    const int i = it * 16 + fr;
    const float rstd = rsqrtf((sSS[i] + sSS[64 + i]) * (1.0f / 256.0f) + EPS_);
    const size_t t = (size_t)c * 64 + i;
    bf16_t* yrow = (bf16_t*)(p.ws + WS_Y) + t * YW + Y_GLA + h * 256;
    const bf16_t* grow = PROJ + pj(t, C_CGATE + h * 256);
    const float* gg = p.in[11] + (size_t)l * 1024 + h * 256;
#pragma unroll
    for (int n8 = 0; n8 < 8; ++n8) { const int vd = (nh * 8 + n8) * 16 + 4 * fq;
        const f32x4 g4 = *(const f32x4*)(gg + vd); const u32x2 gt = *(const u32x2*)(grow + vd);
        u32x2 w; w.x = pk2(o[n8][0] * rstd * g4.x * bflo(gt.x), o[n8][1] * rstd * g4.y * bfhi(gt.x)); w.y = pk2(o[n8][2] * rstd * g4.z * bflo(gt.y), o[n8][3] * rstd * g4.w * bfhi(gt.y));
        *(u32x2*)(yrow + vd) = w; }
}

__device__ __forceinline__ void memkv_item(const Params& p, int item) {
    const int tid = opaque_tid(), lane = tid & 63, wid = tid >> 6, fr = lane & 15, fq = lane >> 4;
    const int l = item >> 6, nt = item & 63;
    const bf16_t* A = (const bf16_t*)(p.ws + WS_MEMN) + (size_t)l * 256 * D_ + (size_t)(wid * 32 + fr) * D_ + fq * 8;
    const bf16_t* B = (const bf16_t*)(p.ws + WS_WT_MEMKV) + (size_t)l * 1024 * D_ + (size_t)(nt * 16 + fr) * D_ + fq * 8;
    f32x4 a0 = (f32x4){0.f, 0.f, 0.f, 0.f}, a1 = (f32x4){0.f, 0.f, 0.f, 0.f};
#pragma unroll 8
    for (int ks = 0; ks < 64; ++ks) { const bf16x8 b = *(const bf16x8*)(B + ks * 32);
        a0 = mfma16(*(const bf16x8*)(A + ks * 32), b, a0); a1 = mfma16(*(const bf16x8*)(A + (size_t)16 * D_ + ks * 32), b, a1); }
    bf16_t* O = (bf16_t*)(p.ws + WS_MEMKV) + (size_t)l * 256 * 1024 + nt * 16 + fr;
#pragma unroll
    for (int j = 0; j < 4; ++j) { O[(size_t)(wid * 32 + fq * 4 + j) * 1024] = (bf16_t)f2bf(a0[j]); O[(size_t)(wid * 32 + 16 + fq * 4 + j) * 1024] = (bf16_t)f2bf(a1[j]); }
}

template <int W>
__device__ __forceinline__ void pool_item(const Params& p, LAS unsigned char* lds, int l, int n, int g) {
    const int tid = opaque_tid(), lane = tid & 63, wid = tid >> 6, fr = lane & 15, fq = lane >> 4;
    LAS bf16_t* sA = (LAS bf16_t*)lds;
    LAS bf16_t* sB = (LAS bf16_t*)(lds + 67584);
    const bf16_t* PROJ = (const bf16_t*)(p.ws + WS_PROJ);
    const bf16_t* WP = (const bf16_t*)(p.ws + WS_WT_POOL) + (size_t)(l * 4 + g) * 65536;
    lds_barrier();
#pragma unroll
    for (int i = 0; i < 8; ++i) { const int id = tid + 512 * i, row = id >> 5, ch = id & 31;
        *(LAS u32x4*)(sB + row * 264 + ch * 8) = *(const u32x4*)(WP + (size_t)row * 256 + ch * 8); }
    {
        const int ch = tid & 31, run = tid >> 5, t0 = n * 128 + run * 8;
        const bf16_t* up = PROJ + pj((size_t)t0, C_AVAL + g * 256 + ch * 8);
        float a[8] = {0.f, 0.f, 0.f, 0.f, 0.f, 0.f, 0.f, 0.f};
#pragma unroll
        for (int j = 1; j < W; ++j) if (t0 - j >= 0) { const u32x4 v = *(const u32x4*)(up - (ptrdiff_t)j * PRS);
            a[0] += bflo(v.x); a[1] += bfhi(v.x); a[2] += bflo(v.y); a[3] += bfhi(v.y); a[4] += bflo(v.z); a[5] += bfhi(v.z); a[6] += bflo(v.w); a[7] += bfhi(v.w); }
#pragma unroll
        for (int sidx = 0; sidx < 8; ++sidx) { const int t = t0 + sidx;
            const u32x4 v = *(const u32x4*)(up + (ptrdiff_t)sidx * PRS);
            const float x[8] = {bflo(v.x), bfhi(v.x), bflo(v.y), bfhi(v.y), bflo(v.z), bfhi(v.z), bflo(v.w), bfhi(v.w)};
#pragma unroll
            for (int e = 0; e < 8; ++e) a[e] += x[e];
            const float ic = 1.0f / (float)((t + 1 < W) ? t + 1 : W);
            u32x4 o; o.x = pk2(a[0] * ic - x[0], a[1] * ic - x[1]); o.y = pk2(a[2] * ic - x[2], a[3] * ic - x[3]);
            o.z = pk2(a[4] * ic - x[4], a[5] * ic - x[5]); o.w = pk2(a[6] * ic - x[6], a[7] * ic - x[7]);
            *(LAS u32x4*)(sA + (run * 8 + sidx) * 264 + ch * 8) = o;
            if (t - W + 1 >= 0) { const u32x4 q = *(const u32x4*)(up + (ptrdiff_t)(sidx - W + 1) * PRS);
                a[0] -= bflo(q.x); a[1] -= bfhi(q.x); a[2] -= bflo(q.y); a[3] -= bfhi(q.y); a[4] -= bflo(q.z); a[5] -= bfhi(q.z); a[6] -= bflo(q.w); a[7] -= bfhi(q.w); }
        }
    }
    lds_barrier();
    bf16x8 af[8];
#pragma unroll
    for (int ks = 0; ks < 8; ++ks) af[ks] = *(const LAS bf16x8*)(sA + (16 * wid + fr) * 264 + ks * 32 + fq * 8);
    const size_t t = (size_t)n * 128 + 16 * wid + fr;
    bf16_t* yrow = (bf16_t*)(p.ws + WS_Y) + t * YW + Y_POOL + g * 256;
    const bf16_t* grow = PROJ + pj(t, C_AGATE + g * 256);
    const float* sc = p.in[8] + (size_t)l * 1024 + g * 256;
#pragma unroll
    for (int half = 0; half < 2; ++half) {
        if (half == 1) {
            lds_barrier();
#pragma unroll
            for (int i = 0; i < 8; ++i) { const int id = tid + 512 * i, row = id >> 5, ch = id & 31;
                *(LAS u32x4*)(sB + row * 264 + ch * 8) = *(const u32x4*)(WP + (size_t)(128 + row) * 256 + ch * 8); }
            lds_barrier();
        }
#pragma unroll
        for (int nt = 0; nt < 8; ++nt) {
            f32x4 acc = (f32x4){0.f, 0.f, 0.f, 0.f};
#pragma unroll
            for (int ks = 0; ks < 8; ++ks) { const bf16x8 bf = *(const LAS bf16x8*)(sB + (nt * 16 + fr) * 264 + ks * 32 + fq * 8); acc = mfma16(bf, af[ks], acc); }
            const int d = half * 128 + nt * 16 + 4 * fq;
            const f32x4 s4 = *(const f32x4*)(sc + d); const u32x2 gt = *(const u32x2*)(grow + d);
            u32x2 w; w.x = pk2(acc[0] * s4.x * bflo(gt.x), acc[1] * s4.y * bfhi(gt.x)); w.y = pk2(acc[2] * s4.z * bflo(gt.y), acc[3] * s4.w * bfhi(gt.y));
            *(u32x2*)(yrow + d) = w;
        }
    }
}

#define XB_TMO      128
#define XB_XCNT(j)  (256  + 64 * (j))
#define XB_XSUB(j)  (1280 + 64 * (j))
#define XB_XGEN(j)  (2304 + 64 * (j))
#define XB_TOP      3328
#define XB_TOPGEN   3392
#define XCD_BAR_WORDS 3456
#define XB_SPIN_CAP (1u << 18)
__device__ __forceinline__ unsigned xb_ld(unsigned* p)              { return __hip_atomic_load(p, __ATOMIC_RELAXED, __HIP_MEMORY_SCOPE_AGENT); }
__device__ __forceinline__ unsigned xb_add(unsigned* p, unsigned v) { return __hip_atomic_fetch_add(p, v, __ATOMIC_RELAXED, __HIP_MEMORY_SCOPE_AGENT); }
__device__ __forceinline__ unsigned xb_xcc_id() { return (unsigned)__builtin_amdgcn_s_getreg((3 << 11) | 20) & 0xFu; }
#define XB_SPIN(cond, bar) do { unsigned _sp = 0; while (cond) { __builtin_amdgcn_s_sleep(1); \
    if ((++_sp & 255u) == 0u) { if (xb_ld(&(bar)[XB_TMO])) break; if (_sp > XB_SPIN_CAP) { atomicAdd(&(bar)[XB_TMO], 1u); break; } } } } while (0)
struct XcdBarrier { unsigned* bar; unsigned x; volatile LAS unsigned* st; };
__device__ __forceinline__ XcdBarrier xcd_barrier_post(unsigned* bar, volatile LAS unsigned* st) {
    XcdBarrier b; b.bar = bar; b.x = xb_xcc_id(); b.st = st;
    if (threadIdx.x == 0) (void)xb_add(&bar[XB_XCNT(b.x)], 1u);
    return b;
}
__device__ __forceinline__ void xcd_barrier_complete(unsigned* bar, unsigned x, unsigned& nloc, unsigned& nx) {
    const unsigned G = gridDim.x * gridDim.y * gridDim.z;
    unsigned sum, cnt, mine, sp = 0u;
    for (;;) {
        sum = 0u; cnt = 0u; mine = 0u;
#pragma unroll
        for (unsigned j = 0; j < 16; ++j) { const unsigned c = xb_ld(&bar[XB_XCNT(j)]); sum += c; cnt += (c > 0u) ? 1u : 0u; mine = (j == x) ? c : mine; }
        if (sum == G) break;
        __builtin_amdgcn_s_sleep(1);
        if ((++sp & 255u) == 0u) { if (xb_ld(&bar[XB_TMO])) break; if (sp > XB_SPIN_CAP) { atomicAdd(&bar[XB_TMO], 1u); break; } }
    }
    nloc = mine > 0u ? mine : 1u; nx = cnt > 0u ? cnt : 1u;
}
__device__ __forceinline__ void xcd_barrier(const XcdBarrier& b) {
    asm volatile("s_waitcnt vmcnt(0)" ::: "memory");
    __syncthreads();
    if (threadIdx.x == 0) {
        unsigned* bar = b.bar;
        __builtin_amdgcn_s_waitcnt(0);
        unsigned nloc = b.st[0], nx = b.st[1];
        if (nloc == 0u) { xcd_barrier_complete(bar, b.x, nloc, nx); b.st[0] = nloc; b.st[1] = nx; }
        const unsigned old = xb_add(&bar[XB_XSUB(b.x)], 1u);
        const unsigned gen = old / nloc;
        if (old + 1u == (gen + 1u) * nloc) {
            __builtin_amdgcn_fence(__ATOMIC_RELEASE, "agent");
            asm volatile("s_waitcnt vmcnt(0)" ::: "memory");
            const unsigned og = xb_add(&bar[XB_TOP], 1u);
            const unsigned tg = og / nx;
            if (og + 1u == (tg + 1u) * nx) xb_add(&bar[XB_TOPGEN], 1u);
            else XB_SPIN(xb_ld(&bar[XB_TOPGEN]) == tg, bar);
            __builtin_amdgcn_fence(__ATOMIC_ACQUIRE, "agent");
            xb_add(&bar[XB_XGEN(b.x)], 1u);
            asm volatile("s_waitcnt vmcnt(0)" ::: "memory");
        } else {
            XB_SPIN(xb_ld(&bar[XB_XGEN(b.x)]) == gen, bar);
            __builtin_amdgcn_fence(__ATOMIC_ACQUIRE, "agent");
            asm volatile("s_waitcnt vmcnt(0)" ::: "memory");
        }
    }
    __syncthreads();
}

__global__ void __launch_bounds__(512, 2) fwd_megakernel(Params p) {
    extern __shared__ __attribute__((aligned(16))) unsigned char lds_raw[];
    LAS unsigned char* lds = (LAS unsigned char*)lds_raw;
    cg::grid_group grid = cg::this_grid();
    const int G = gridDim.x, bx = blockIdx.x;
    const int vcu = (G % 8 == 0) ? (bx % 8) * (G / 8) + bx / 8 : bx;
    bf16_t* PROJ = (bf16_t*)(p.ws + WS_PROJ);
    bf16_t* Y = (bf16_t*)(p.ws + WS_Y);

    {
        if (threadIdx.x < 4) ((LAS unsigned*)(lds + LDS_BYTES - 16))[threadIdx.x] = 0u;
        __syncthreads();
    }
    const XcdBarrier xbar = xcd_barrier_post((unsigned*)(p.ws + WS_CTL), (volatile LAS unsigned*)(lds + LDS_BYTES - 16));
    for (int rep = 0; rep < NREP(1); ++rep) phase_rows(p, lds, 0);
    xcd_barrier(xbar);
    if (p.out == nullptr) grid.sync();

#pragma unroll 1
    for (int l = 0; l < 2; ++l) {
        for (int rep = 0; rep < NREP(2); ++rep) {
            __syncthreads();
            SchedProj sch{(const char*)(p.ws + WS_HREG), (const char*)(p.ws + WS_WT_IN), G, bx};
            EpiBf16 epi{PROJ, NP, p.in[6] + (size_t)l * 8192, 0};
            gemm_phase(lds, D_, D_, sch, epi);
            lr_gemm(p, lds, l);
        }
        GSYNC();
        for (int rep = 0; rep < NREP(4); ++rep) {
            if (l == 0) for (int it = G - 1 - bx; it < 128; it += G) memkv_item(p, it);
            {
                unsigned* qhead = (unsigned*)(p.ws + WS_CTL) + 4096 + ((0 * 2 + l) * 8 + (bx & 7)) * 64;
                LAS int* sq = (LAS int*)(lds + LDS_BYTES - 32);
                const int xbase = (bx & 7) * (G / 8);
                for (;;) {
                    if (threadIdx.x == 0) *sq = (int)__hip_atomic_fetch_add(qhead, 1u, __ATOMIC_RELAXED, __HIP_MEMORY_SCOPE_AGENT);
                    lds_barrier();
                    const int q = *sq;
                    if (q >= 320) break;
                    if (q < 192) {
                        const int it = xbase + (q & 31) + 256 * (q >> 5);
                        const int g = it >> 9, x = it & 511, hs = x & 3, y = x >> 2;
                        const int dil = (g == 0) ? 1 : (g == 1 ? 4 : 16);
                        const int n = y / dil, r = y % dil;
                        const int h12 = g * 4 + hs;
                        const float slope = exp2f(-8.0f * (float)(h12 + 1) / 12.0f);
                        const size_t t0 = (size_t)n * 128 * dil + r;
                        const bf16_t* qb = PROJ + pj(t0, C_SQ + h12 * 128);
                        const bf16_t* kb = PROJ + pj(0, C_SK + h12 * 128) + (ptrdiff_t)((ptrdiff_t)t0 - (ptrdiff_t)128 * dil) * PRS;
                        const bf16_t* vb = PROJ + pj(0, C_SV + h12 * 128) + (ptrdiff_t)((ptrdiff_t)t0 - (ptrdiff_t)128 * dil) * PRS;
                        bf16_t* ob = (bf16_t*)(p.ws + WS_SWAO) + ((size_t)g * S_ + t0) * 512 + hs * 128;
                        float* lb = (float*)(p.ws + WS_LSE) + ((size_t)g * S_ + t0) * 4 + hs;
                        attn_item<1, 10>(lds, qb, (size_t)dil * PRS, kb, vb, (size_t)dil * PRS, n == 0, slope * (float)dil, ob, (size_t)dil * 512, nullptr, 0, lb, (size_t)dil * 4);
                    } else {
                        const int q2 = q - 192;
                        gla_kv_item(p, lds, l, xbase + (q2 & 31) + 256 * (q2 >> 5));
                    }
                }
            }
        }
        GSYNC();
        for (int rep = 0; rep < NREP(8); ++rep) {
            const int tid = opaque_tid();
            const int wvD = __builtin_amdgcn_readfirstlane(tid >> 6);
            __syncthreads();
            if (tid == 0) *(LAS int*)(lds + 90112) = 0;
            __syncthreads();
            if (wvD < 4) {
                const bf16_t* KV = (const bf16_t*)(p.ws + WS_BIG); const float* DEC = (const float*)(p.ws + WS_DEC); bf16_t* SP = (bf16_t*)(p.ws + WS_SP);
                for (int rep2 = 0; rep2 < NREP(0x800); ++rep2) for (size_t e2 = (size_t)bx * 256 + tid; e2 < 65536; e2 += (size_t)G * 256) {
                    const int h = (int)(e2 >> 14), rest = (int)(e2 & 16383) * 2, kd = rest & 127;
                    float st0 = 0.f, st1 = 0.f;
#pragma unroll 1
                    for (int c0 = 0; c0 < 256; c0 += 32) {
                        unsigned kvv[32]; f32x2 dd[32];
#pragma unroll
                        for (int i = 0; i < 32; ++i) { const int c = c0 + i;
                            kvv[i] = *(const unsigned*)(KV + (size_t)(c * 4 + h) * 32768 + rest);
                            dd[i] = *(const f32x2*)(DEC + (c * 4 + h) * 128 + kd); }
#pragma unroll
                        for (int i = 0; i < 32; ++i) { const int c = c0 + i;
                            *(unsigned*)(SP + (size_t)(c * 4 + h) * 32768 + rest) = pk2(st0, st1);
                            st0 = dd[i].x * st0 + bflo(kvv[i]); st1 = dd[i].y * st1 + bfhi(kvv[i]); }
                    }
                }
            } else {
                const bf16_t* SO = (const bf16_t*)(p.ws + WS_SWAO); const float* LSE = (const float*)(p.ws + WS_LSE);
                for (size_t w = (size_t)bx * 256 + (tid - 256); w < (size_t)S_ * 64; w += (size_t)G * 256) {
                    const size_t t = w >> 6; const int hs = (int)(w >> 4) & 3, d8 = (int)(w & 15) * 8;
                    const float l0 = LSE[(0 * (size_t)S_ + t) * 4 + hs], l1 = LSE[(1 * (size_t)S_ + t) * 4 + hs], l2 = LSE[(2 * (size_t)S_ + t) * 4 + hs];
                    const float m = fmaxf(l0, fmaxf(l1, l2));
                    float e0 = __expf(l0 - m), e1 = __expf(l1 - m), e2 = __expf(l2 - m);
                    const float is = 1.0f / (e0 + e1 + e2); e0 *= is; e1 *= is; e2 *= is;
                    const u32x4 a = *(const u32x4*)(SO + (0 * (size_t)S_ + t) * 512 + hs * 128 + d8);
                    const u32x4 b = *(const u32x4*)(SO + (1 * (size_t)S_ + t) * 512 + hs * 128 + d8);
                    const u32x4 c = *(const u32x4*)(SO + (2 * (size_t)S_ + t) * 512 + hs * 128 + d8);
                    const u32x4 g = *(const u32x4*)(PROJ + pj(t, C_SGATE + hs * 128 + d8));
                    u32x4 o;
                    o.x = pk2((e0 * bflo(a.x) + e1 * bflo(b.x) + e2 * bflo(c.x)) * bflo(g.x), (e0 * bfhi(a.x) + e1 * bfhi(b.x) + e2 * bfhi(c.x)) * bfhi(g.x));
                    o.y = pk2((e0 * bflo(a.y) + e1 * bflo(b.y) + e2 * bflo(c.y)) * bflo(g.y), (e0 * bfhi(a.y) + e1 * bfhi(b.y) + e2 * bfhi(c.y)) * bfhi(g.y));
                    o.z = pk2((e0 * bflo(a.z) + e1 * bflo(b.z) + e2 * bflo(c.z)) * bflo(g.z), (e0 * bfhi(a.z) + e1 * bfhi(b.z) + e2 * bfhi(c.z)) * bfhi(g.z));
                    o.w = pk2((e0 * bflo(a.w) + e1 * bflo(b.w) + e2 * bflo(c.w)) * bflo(g.w), (e0 * bfhi(a.w) + e1 * bfhi(b.w) + e2 * bfhi(c.w)) * bfhi(g.w));
                    *(u32x4*)(Y + t * YW + Y_SWA + hs * 128 + d8) = o;
                }
            }
            {
                LAS int* ctr = (LAS int*)(lds + 90112);
                const int nitems = (l == 0) ? 9728 + 2560 : 2560;
                for (;;) {
                    int idx = 0; if ((tid & 63) == 0) idx = __hip_atomic_fetch_add(ctr, 1, __ATOMIC_RELAXED, __HIP_MEMORY_SCOPE_WORKGROUP);
                    idx = __builtin_amdgcn_readfirstlane(idx);
                    const int id = bx + G * idx; if (id >= nitems) break;
                    if (l == 0 && id < 9728) cvt_win_item(p, 1, (LAS float*)(lds + wvD * 10240), id, tid & 63);
                    else cvt_brout_item(p, l, (LAS float*)(lds + wvD * 10240), (l == 0) ? id - 9728 : id, tid & 63);
                }
            }
            __syncthreads();
            {
                unsigned* qhead = (unsigned*)(p.ws + WS_CTL) + 4096 + ((1 * 2 + l) * 8 + (bx & 7)) * 64;
                LAS int* sq = (LAS int*)(lds + LDS_BYTES - 32);
                const int xbase = (bx & 7) * (G / 8);
                for (;;) {
                    if (threadIdx.x == 0) *sq = (int)__hip_atomic_fetch_add(qhead, 1u, __ATOMIC_RELAXED, __HIP_MEMORY_SCOPE_AGENT);
                    lds_barrier();
                    const int q = *sq;
                    if (q >= 128) break;
                    const int q2 = q & 63, it = xbase + (q2 & 31) + 256 * (q2 >> 5);
                    if (q < 64) {
                        const int n = it >> 2, g = it & 3;
                        if (g == 0) pool_item<2>(p, lds, l, n, 0); else if (g == 1) pool_item<4>(p, lds, l, n, 1); else if (g == 2) pool_item<8>(p, lds, l, n, 2); else pool_item<16>(p, lds, l, n, 3);
                    } else {
                        const int n = it >> 2, h = it & 3;
                        const size_t t0 = (size_t)n * 128;
                        const bf16_t* mk = (const bf16_t*)(p.ws + WS_MEMKV) + (size_t)l * 256 * 1024;
                        attn_item<0, 16>(lds, PROJ + pj(t0, C_MQ + h * 128), PRS, mk + h * 128, mk + 512 + h * 128, 1024, false, 0.f,
                                     Y + t0 * YW + Y_MEM + h * 128, YW, PROJ + pj(t0, C_MGATE + h * 128), PRS, nullptr, 0);
                    }
                }
            }
        }
        GSYNC();
        {
            unsigned* qhead = (unsigned*)(p.ws + WS_CTL) + 4096 + ((2 * 2 + l) * 8 + (bx & 7)) * 64;
            LAS int* sq = (LAS int*)(lds + LDS_BYTES - 32);
            const int xbase = (bx & 7) * (G / 8);
            for (;;) {
                if (threadIdx.x == 0) *sq = (int)__hip_atomic_fetch_add(qhead, 1u, __ATOMIC_RELAXED, __HIP_MEMORY_SCOPE_AGENT);
                lds_barrier();
                const int q = *sq;
                if (q >= 128) break;
                gla_out_item(p, lds, l, xbase + (q & 31) + 256 * (q >> 5));
            }
        }
        GSYNC();
        for (int rep = 0; rep < NREP(32); ++rep) {
            __syncthreads();
            SchedMerge sch{(const char*)(p.ws + WS_Y), (const char*)(p.ws + WS_WT_BR) + (size_t)l * D_ * YW * 2, G, vcu};
            EpiMerge epi{(bf16_t*)(p.ws + WS_HREG), PROJ};
            gemm_phase(lds, YW, YW, sch, epi);
        }
        GSYNC();
        for (int rep = 0; rep < NREP(64); ++rep) {
            __syncthreads();
            SchedOut sch{(const char*)(p.ws + WS_HREG), (const char*)(p.ws + WS_WT_OUT) + (size_t)l * D_ * D_ * 2, G, vcu};
            EpiU epi{(bf16_t*)(p.ws + WS_BIG)};
            gemm_phase(lds, D_, D_, sch, epi);
        }
        GSYNC();
        __syncthreads();
        if (PH & 1024) phase_rows(p, lds, l + 1);
        if (l == 0) GSYNC();
    }
}

extern "C" void kernel_launch(void* const* d_in, const int* in_sizes, int n_in,
                              void* d_out, int out_size, void* d_ws, size_t ws_size,
                              hipStream_t stream) {
    static int grid_blocks = 0;
    if (!grid_blocks) {
        int dev = 0, cus = 0, per_cu = 0;
        hipGetDevice(&dev);
        hipDeviceGetAttribute(&cus, hipDeviceAttributeMultiprocessorCount, dev);
        hipFuncSetAttribute((const void*)fwd_megakernel, hipFuncAttributeMaxDynamicSharedMemorySize, LDS_BYTES);
        hipOccupancyMaxActiveBlocksPerMultiprocessor(&per_cu, (const void*)fwd_megakernel, NTHREADS, LDS_BYTES);
        (void)hipGetLastError();
        grid_blocks = cus;
        if (ws_size < WS_END || n_in != 18) { fprintf(stderr, "kernel_launch: workspace %zu < %zu or n_in %d != 18\n", ws_size, (size_t)WS_END, n_in); grid_blocks = -1; }
    }
    if (grid_blocks < 0) return;
    if (hipMemsetAsync((char*)d_ws + WS_CTL, 0, CTL_BYTES, stream) != hipSuccess) { fprintf(stderr, "kernel_launch: memset of the barrier words failed\n"); return; }
    Params p{};
    for (int i = 0; i < 18; ++i) p.in[i] = (const float*)d_in[i];
    p.out = (float*)d_out;
    p.ws = (unsigned char*)d_ws;
    void* args[] = {&p};
    hipError_t e = hipLaunchCooperativeKernel((const void*)fwd_megakernel, dim3(grid_blocks), dim3(NTHREADS), args, LDS_BYTES, stream);
    if (e != hipSuccess) fprintf(stderr, "cooperative launch failed: %s (grid %d)\n", hipGetErrorString(e), grid_blocks);
}
```

```cpp
#include <hip/hip_runtime.h>
#include <hip/hip_cooperative_groups.h>
#include <cstdio>
#include <cstdint>
namespace cg = cooperative_groups;

#define LAS __attribute__((address_space(3)))
typedef unsigned short bf16_t;
typedef short bf16x8 __attribute__((ext_vector_type(8)));
typedef float f32x4 __attribute__((ext_vector_type(4)));
typedef unsigned u32x4 __attribute__((ext_vector_type(4)));
typedef unsigned u32x2 __attribute__((ext_vector_type(2)));
typedef float f32x2 __attribute__((ext_vector_type(2)));

constexpr int S_ = 16384, D_ = 2048, NP = 19456, DIN = 19472;
constexpr int C_AVAL = 0, C_AGATE = 1024, C_SQ = 2048, C_SK = 3584, C_SV = 5120, C_SGATE = 6656, C_CQ = 7168, C_CK = 7680,
              C_CV = 8192, C_CGATE = 9216, C_MQ = 10240, C_MGATE = 10752, C_GL = 11264;
constexpr int YW = 3072, Y_POOL = 0, Y_SWA = 1024, Y_GLA = 1536, Y_MEM = 2560;
constexpr float EPS_ = 1e-6f, NEG_ = -1e30f;

__host__ __device__ __forceinline__ constexpr size_t pj(size_t t, int c) { return (size_t)(c >> 8) * ((size_t)16384 * 256) + t * 256 + (size_t)(c & 255); }
constexpr int PRS = 256;

constexpr size_t MiB = 1ull << 20;
constexpr size_t WS_WT_IN = 0;
constexpr size_t WS_WT_BR = 76 * MiB;
constexpr size_t WS_WT_OUT = 100 * MiB;
constexpr size_t WS_WT_MEMKV = 116 * MiB;
constexpr size_t WS_WT_POOL = 124 * MiB;
constexpr size_t WS_WT_LR = 125 * MiB;
constexpr size_t WS_MEMN = 126 * MiB;
constexpr size_t WS_MEMKV = 128 * MiB;
constexpr size_t WS_CTL = 129 * MiB;
constexpr size_t CTL_BYTES = 32768;
constexpr size_t WS_LSE = 130 * MiB;
constexpr size_t WS_DEC = 131 * MiB;
constexpr size_t WS_HREG = 134 * MiB;
constexpr size_t WS_Y = 198 * MiB;
constexpr size_t WS_SWAO = 294 * MiB;
constexpr size_t WS_SP = 342 * MiB;
constexpr size_t WS_BIG = 406 * MiB;
constexpr size_t WS_PROJ = 534 * MiB;
constexpr size_t WS_BC = 1142 * MiB;
constexpr size_t WS_END = 1174 * MiB;

#ifndef PH
#define PH 0xffff
#endif
#ifndef REP
#define REP 0
#endif
#define NREP(m) ((REP & (m)) ? 2 : 1)
#define GSYNC() do { xcd_barrier(xbar); if (REP & 0x2000) xcd_barrier(xbar); } while (0)
constexpr int LDS_BYTES = 144 * 1024;
constexpr int NTHREADS = 512;

struct Params {
    const float* in[18];
    float* out;
    unsigned char* ws;
};

#define LDS_WAIT() asm volatile("s_waitcnt lgkmcnt(0)" ::: "memory")
__device__ __forceinline__ unsigned f2bf(float f) { unsigned u = __float_as_uint(f); return (u + 0x7fffu + ((u >> 16) & 1u)) >> 16; }
typedef __bf16 bf16x2_t __attribute__((ext_vector_type(2)));
__device__ __forceinline__ unsigned pk2(float lo, float hi) { const bf16x2_t v = {(__bf16)lo, (__bf16)hi}; return __builtin_bit_cast(unsigned, v); }
__device__ __forceinline__ float bf2f(bf16_t b) { return __uint_as_float(((unsigned)b) << 16); }
__device__ __forceinline__ float bflo(unsigned w) { return __uint_as_float(w << 16); }
__device__ __forceinline__ float bfhi(unsigned w) { return __uint_as_float(w & 0xffff0000u); }
__device__ __forceinline__ float sigmoidf_(float x) { return __builtin_amdgcn_rcpf(1.0f + __expf(-x)); }
__device__ __forceinline__ float siluf_(float x) { return x * sigmoidf_(x); }
__device__ __forceinline__ float wave_sum(float v) {
#pragma unroll
    for (int o = 1; o < 64; o <<= 1) v += __shfl_xor(v, o);
    return v;
}
__device__ __forceinline__ int opaque_tid() { int t = threadIdx.x; asm volatile("" : "+v"(t)); return t; }
__device__ __forceinline__ void lds_barrier() { asm volatile("s_waitcnt lgkmcnt(0)\n\ts_barrier" ::: "memory"); }
__device__ __forceinline__ f32x4 mfma16(bf16x8 a, bf16x8 b, f32x4 c) { return __builtin_amdgcn_mfma_f32_16x16x32_bf16(a, b, c, 0, 0, 0); }

constexpr int HTB = 128 * 64 * 2;
__device__ __forceinline__ int lds_byte(int r, int c) { const int st = (r >> 4) * 2 + (c >> 5), rr = r & 15, cc = c & 31, ob = rr * 64 + cc * 2; return st * 1024 + (ob ^ (((ob >> 9) & 1) << 5)); }
__device__ __forceinline__ void stage_rc(int b, int& R, int& C) { const int st = b / 1024, sb = b % 1024, swz = sb ^ (((sb >> 9) & 1) << 5); R = (st >> 1) * 16 + swz / 64; C = (st & 1) * 32 + (swz % 64) / 2; }
__device__ __forceinline__ int perm32(int rho) { const int n = rho >> 4, i = rho & 15; return 8 * (i >> 2) + 4 * n + (i & 3); }

struct GUnit { const char* A; const char* B; int nt, pm, pn, tag; };

template <class Sched, class Epi>
__device__ __forceinline__ void gemm_phase(LAS unsigned char* lds, const int lda, const int ldb, const Sched& S, const Epi& E) {
    const int tid = opaque_tid(), wid = __builtin_amdgcn_readfirstlane(tid >> 6), lane = tid & 63, wr = wid >> 2, wc = wid & 3, fr = lane & 15, fq = lane >> 4;
    unsigned voffA[2], voffB[2];
#pragma unroll
    for (int i = 0; i < 2; ++i) { int R, C; stage_rc(tid * 16 + i * 8192, R, C); const int Rb = (R & ~31) + perm32(R & 31);
        voffA[i] = (unsigned)(R * lda + C) * 2u; voffB[i] = (unsigned)(Rb * ldb + C) * 2u; }
    const size_t kstep = 128;
    const size_t hstepA = (size_t)128 * lda * 2, hstepB = (size_t)128 * ldb * 2;
    const unsigned ldsw = (unsigned)wid * 1024u;
    const int aoff = lds_byte(wr * 64 + fr, fq * 8), boff = lds_byte(wc * 32 + fr, fq * 8);
#define G_SA(b, h) (((b) * 2 + (h)) * HTB)
#define G_SB(b, h) ((4 + (b) * 2 + (h)) * HTB)
#define G_STAGE(bufoff, gbase, voff) do { _Pragma("unroll") for (int _i = 0; _i < 2; ++_i) \
        __builtin_amdgcn_global_load_lds((const unsigned*)((const char*)(gbase) + (voff)[_i]), (LAS unsigned*)(lds + (bufoff) + ldsw + _i * 8192), 16, 0, 0); } while (0)
#define G_LDA(dst, b, h) do { _Pragma("unroll") for (int m = 0; m < 4; ++m) _Pragma("unroll") for (int k = 0; k < 2; ++k) dst[m][k] = *(const LAS bf16x8*)(lds + G_SA(b, h) + aoff + m * 2048 + k * 1024); } while (0)
#define G_LDB(dst, b, h) do { _Pragma("unroll") for (int n = 0; n < 2; ++n) _Pragma("unroll") for (int k = 0; k < 2; ++k) dst[n][k] = *(const LAS bf16x8*)(lds + G_SB(b, h) + boff + n * 2048 + k * 1024); } while (0)
#define G_MMA(ai, bj, At, Bt) do { __builtin_amdgcn_s_setprio(1); _Pragma("unroll") for (int m = 0; m < 4; ++m) _Pragma("unroll") for (int n = 0; n < 2; ++n) _Pragma("unroll") for (int k = 0; k < 2; ++k) \
        acc[ai][bj][m][n] = __builtin_amdgcn_mfma_f32_16x16x32_bf16(Bt[n][k], At[m][k], acc[ai][bj][m][n], 0, 0, 0); __builtin_amdgcn_s_setprio(0); } while (0)
#define G_WAIT_V(n) asm volatile("s_waitcnt vmcnt(" #n ")" ::: "memory")
#define G_WAIT_L(n) asm volatile("s_waitcnt lgkmcnt(" #n ")" ::: "memory")
#define G_BAR __builtin_amdgcn_s_barrier()
#define G_SCHED __builtin_amdgcn_sched_barrier(0)
    GUnit cur, nxt; int ui = 0;
    if (!S.next(0, cur)) return;
    f32x4 acc[2][2][4][2];
#pragma unroll
    for (int a = 0; a < 2; ++a)
#pragma unroll
        for (int b = 0; b < 2; ++b)
#pragma unroll
            for (int m = 0; m < 4; ++m)
#pragma unroll
                for (int n = 0; n < 2; ++n) acc[a][b][m][n] = (f32x4){0.f, 0.f, 0.f, 0.f};
    bf16x8 At[4][2], B0[2][2], B1[2][2];
    const char* cA = cur.A; const char* cB = cur.B;
    G_STAGE(G_SB(0, 0), cB, voffB); G_STAGE(G_SB(0, 1), cB + hstepB, voffB); G_STAGE(G_SA(0, 0), cA, voffA); G_STAGE(G_SA(0, 1), cA + hstepA, voffA);
    if (wr == 1) G_BAR;
    G_WAIT_V(2); G_BAR;
    G_STAGE(G_SB(1, 0), cB + kstep, voffB); G_STAGE(G_SA(1, 0), cA + kstep, voffA); G_STAGE(G_SB(1, 1), cB + hstepB + kstep, voffB);
    G_WAIT_V(6); G_BAR;
    for (;;) {
        const bool has_next = S.next(ui + 1, nxt);
        const char* nA = has_next ? nxt.A : cA; const char* nB = has_next ? nxt.B : cB;
        int nt = cur.nt; asm volatile("" : "+s"(nt));
        for (int t = 0; t < nt; t += 2) {
            const bool last = (t == nt - 2);
            const char* a1 = cA + (size_t)(t + 1) * kstep;
            const char* a2 = last ? nA : cA + (size_t)(t + 2) * kstep; const char* b2 = last ? nB : cB + (size_t)(t + 2) * kstep;
            const char* a3 = a2 + kstep; const char* b3 = b2 + kstep;
            G_LDB(B0, 0, 0); G_LDB(B1, 0, 1); G_SCHED; G_LDA(At, 0, 0); G_STAGE(G_SA(1, 1), a1 + hstepA, voffA);
            G_WAIT_V(8); G_WAIT_L(0); G_BAR; G_MMA(0, 0, At, B0); G_MMA(0, 1, At, B1); G_BAR; G_SCHED;
            G_LDA(At, 0, 1); G_STAGE(G_SB(0, 0), b2, voffB); G_STAGE(G_SB(0, 1), b2 + hstepB, voffB); G_STAGE(G_SA(0, 0), a2, voffA);
            G_WAIT_V(8); G_WAIT_L(0); G_BAR; G_MMA(1, 0, At, B0); G_MMA(1, 1, At, B1); G_BAR; G_SCHED;
            G_LDB(B0, 1, 0); G_LDB(B1, 1, 1); G_SCHED; G_LDA(At, 1, 0); G_STAGE(G_SA(0, 1), a2 + hstepA, voffA);
            G_WAIT_V(8); G_WAIT_L(0); G_BAR; G_MMA(0, 0, At, B0); G_MMA(0, 1, At, B1); G_BAR; G_SCHED;
            G_LDA(At, 1, 1); G_STAGE(G_SB(1, 0), b3, voffB); G_STAGE(G_SB(1, 1), b3 + hstepB, voffB); G_STAGE(G_SA(1, 0), a3, voffA);
            G_WAIT_V(8); G_WAIT_L(0); G_BAR; G_MMA(1, 0, At, B0); G_MMA(1, 1, At, B1); G_BAR; G_SCHED;
        }
        if (wr == 0) G_BAR;
        const bool keep = E(acc, cur, wr, wc, fr, fq);
        if (!has_next) break;
        if (!keep)
#pragma unroll
        for (int a = 0; a < 2; ++a)
#pragma unroll
            for (int b = 0; b < 2; ++b)
#pragma unroll
                for (int m = 0; m < 4; ++m)
#pragma unroll
                    for (int n = 0; n < 2; ++n) acc[a][b][m][n] = (f32x4){0.f, 0.f, 0.f, 0.f};
        cur = nxt; cA = nA; cB = nB; ++ui;
        if (wr == 1) G_BAR;
    }
    G_WAIT_V(0);
    G_BAR;
#undef G_SA
#undef G_SB
#undef G_STAGE
#undef G_LDA
#undef G_LDB
#undef G_MMA
#undef G_WAIT_V
#undef G_WAIT_L
#undef G_BAR
#undef G_SCHED
}

struct SchedProj {
    const char* A; const char* B; int G, c;
    __device__ __forceinline__ bool next(int i, GUnit& u) const {
        constexpr int nM = 64, nN = 76, nwg = nM * nN, NXCD = 8, WGM = 4;
        const int L = i * G + c; if (L >= nwg) return false;
        int wgid = L; { const int q = nwg / NXCD, r = nwg % NXCD, xcd = wgid % NXCD, off = wgid / NXCD; wgid = (xcd < r ? xcd * (q + 1) : r * (q + 1) + (xcd - r) * q) + off; }
        const int nig = WGM * nN, gid = wgid / nig, fm = gid * WGM, gsz = (nM - fm) < WGM ? (nM - fm) : WGM;
        u.pm = fm + ((wgid % nig) % gsz); u.pn = (wgid % nig) / gsz;
        u.A = A + (size_t)u.pm * 256 * D_ * 2; u.B = B + (size_t)u.pn * 256 * D_ * 2; u.nt = 32;
        const int pn = u.pn;
        u.tag = (pn >= 44) ? 2 : (((pn >= 4 && pn < 8) || pn == 26 || pn == 27 || (pn >= 36 && pn < 40) || pn == 42 || pn == 43) ? 1 : 0);
        return true;
    }
};
struct SchedMemKV {
    const char* A; const char* B; int b;
    __device__ __forceinline__ bool next(int i, GUnit& u) const {
        if (i > 0 || b >= 8) return false;
        const int ly = b >> 2; u.pm = ly; u.pn = b & 3; u.tag = 0; u.nt = 32;
        u.A = A + (size_t)ly * 256 * D_ * 2; u.B = B + ((size_t)ly * 1024 + (size_t)u.pn * 256) * D_ * 2;
        return true;
    }
};
struct SchedPool {
    const char* A; const char* B; int G, vcu;
    __device__ __forceinline__ bool next(int i, GUnit& u) const {
        const int T = vcu + G * i; if (T >= 256) return false;
        u.pm = T >> 2; u.pn = T & 3; u.tag = 0; u.nt = 4;
        u.A = A + ((size_t)u.pm * 256 * 1024 + (size_t)u.pn * 256) * 2; u.B = B + (size_t)u.pn * 65536 * 2;
        return true;
    }
};
struct SchedMerge {
    const char* A; const char* B; int G, vcu;
    __device__ __forceinline__ bool next(int i, GUnit& u) const {
        const int T = vcu + G * (i >> 2); if (T >= 512) return false;
        const int br = i & 3;
        const int koff = (br == 0) ? 0 : (br == 1 ? 1024 : (br == 2 ? 1536 : 2560));
        u.pm = T >> 3; u.pn = T & 7; u.tag = br; u.nt = (br & 1) ? 8 : 16;
        u.A = A + ((size_t)u.pm * 256 * YW + koff) * 2; u.B = B + ((size_t)u.pn * 256 * YW + koff) * 2;
        return true;
    }
};
struct SchedOut {
    const char* A; const char* B; int G, vcu;
    __device__ __forceinline__ bool next(int i, GUnit& u) const {
        const int T = vcu + G * i; if (T >= 512) return false;
        u.pm = T >> 3; u.pn = T & 7; u.tag = 0; u.nt = 32;
        u.A = A + (size_t)u.pm * 256 * D_ * 2; u.B = B + (size_t)u.pn * 256 * D_ * 2;
        return true;
    }
};

struct EpiBf16 {
    bf16_t* O; int ldc; const float* bias; int rowsel;
    __device__ __forceinline__ bool operator()(f32x4 (&acc)[2][2][4][2], const GUnit& u, int wr, int wc, int fr, int fq) const {
        const int mode = u.tag;
        const int row0 = u.pm * 256 + wr * 64 + fr;
        if (mode == 2) {
            const int chn0 = (u.pn - 44) * 64 + wc * 16 + fq * 4;
            const f32x4 bb0 = *(const f32x4*)(bias + chn0), bb1 = *(const f32x4*)(bias + 2048 + chn0), bb2 = *(const f32x4*)(bias + 4096 + chn0), bb3 = *(const f32x4*)(bias + 6144 + chn0);
#pragma unroll
            for (int ai = 0; ai < 2; ++ai)
#pragma unroll
                for (int m = 0; m < 4; ++m) {
                    bf16_t* rowp = O + pj((size_t)(row0 + ai * 128 + m * 16), C_GL + chn0);
                    const f32x4 z0 = acc[ai][0][m][0] + bb0, z1 = acc[ai][0][m][1] + bb1, z2 = acc[ai][1][m][0] + bb2, z3 = acc[ai][1][m][1] + bb3;
                    f32x4 r0, r1, r2, r3;
#pragma unroll
                    for (int j = 0; j < 4; ++j) {
                        const float E0 = fminf(1.0f + __expf(-z0[j]), 1e30f), E1 = fminf(1.0f + __expf(-z1[j]), 1e30f), E2 = fminf(1.0f + __expf(-z2[j]), 1e30f), E3 = fminf(1.0f + __expf(-z3[j]), 1e30f);
                        const float i0 = __builtin_amdgcn_rcpf(E0), i1 = __builtin_amdgcn_rcpf(E1), i2 = __builtin_amdgcn_rcpf(E2), i3 = __builtin_amdgcn_rcpf(E3);
                        r0[j] = E1 * i0; r1[j] = E2 * i1; r2[j] = E3 * i2; r3[j] = i3;
                    }
                    u32x2 w;
                    w.x = pk2(r0[0], r0[1]); w.y = pk2(r0[2], r0[3]); *(u32x2*)(rowp) = w;
                    w.x = pk2(r1[0], r1[1]); w.y = pk2(r1[2], r1[3]); *(u32x2*)(rowp + 8 * (size_t)16384 * 256) = w;
                    w.x = pk2(r2[0], r2[1]); w.y = pk2(r2[2], r2[3]); *(u32x2*)(rowp + 16 * (size_t)16384 * 256) = w;
                    w.x = pk2(r3[0], r3[1]); w.y = pk2(r3[2], r3[3]); *(u32x2*)(rowp + 24 * (size_t)16384 * 256) = w;
                }
            return false;
        }
        const int col0 = u.pn * 256 + wc * 32 + 8 * fq;
#pragma unroll
        for (int bj = 0; bj < 2; ++bj)
#pragma unroll
            for (int ai = 0; ai < 2; ++ai)
#pragma unroll
                for (int m = 0; m < 4; ++m) {
                    bf16_t* rowp = O + pj((size_t)(row0 + ai * 128 + m * 16), col0 + bj * 128);
                    f32x4 v0 = acc[ai][bj][m][0], v1 = acc[ai][bj][m][1];
                    if (mode != 0) {
#pragma unroll
                        for (int j = 0; j < 4; ++j) { v0[j] = siluf_(v0[j]); v1[j] = siluf_(v1[j]); }
                    }
                    u32x4 w; w.x = pk2(v0[0], v0[1]); w.y = pk2(v0[2], v0[3]); w.z = pk2(v1[0], v1[1]); w.w = pk2(v1[2], v1[3]);
                    *(u32x4*)rowp = w;
                }
        return false;
    }
};
struct EpiPool {
    bf16_t* Y; const bf16_t* proj; const float* scale;
    __device__ __forceinline__ bool operator()(f32x4 (&acc)[2][2][4][2], const GUnit& u, int wr, int wc, int fr, int fq) const {
        const int row0 = u.pm * 256 + wr * 64 + fr, col0 = u.pn * 256 + wc * 32 + 8 * fq;
        f32x4 sc[2][2];
#pragma unroll
        for (int bj = 0; bj < 2; ++bj) { sc[bj][0] = *(const f32x4*)(scale + col0 + bj * 128); sc[bj][1] = *(const f32x4*)(scale + col0 + bj * 128 + 4); }
#pragma unroll
        for (int ai = 0; ai < 2; ++ai) {
            u32x4 g[4][2];
#pragma unroll
            for (int m = 0; m < 4; ++m)
#pragma unroll
                for (int bj = 0; bj < 2; ++bj) g[m][bj] = *(const u32x4*)(proj + pj((size_t)(row0 + ai * 128 + m * 16), C_AGATE + col0 + bj * 128));
#pragma unroll
            for (int m = 0; m < 4; ++m) {
                const size_t row = (size_t)(row0 + ai * 128 + m * 16);
#pragma unroll
                for (int bj = 0; bj < 2; ++bj) {
                    const u32x4 gg = g[m][bj];
                    const f32x4 v0 = acc[ai][bj][m][0] * sc[bj][0], v1 = acc[ai][bj][m][1] * sc[bj][1];
                    u32x4 w; w.x = pk2(v0[0] * bflo(gg.x), v0[1] * bfhi(gg.x)); w.y = pk2(v0[2] * bflo(gg.y), v0[3] * bfhi(gg.y));
                    w.z = pk2(v1[0] * bflo(gg.z), v1[1] * bfhi(gg.z)); w.w = pk2(v1[2] * bflo(gg.w), v1[3] * bfhi(gg.w));
                    *(u32x4*)(Y + row * YW + col0 + bj * 128) = w;
                }
            }
            asm volatile("" ::: "memory");
        }
        return false;
    }
};
struct EpiMerge {
    bf16_t* M; const bf16_t* proj;
    __device__ __forceinline__ bool operator()(f32x4 (&acc)[2][2][4][2], const GUnit& u, int wr, int wc, int fr, int fq) const {
        const int br = u.tag;
        const int row0 = u.pm * 256 + wr * 64 + fr, col0 = u.pn * 256 + wc * 32 + 8 * fq;
#pragma unroll
        for (int ai = 0; ai < 2; ++ai) {
            u32x4 g[4][2];
#pragma unroll
            for (int m = 0; m < 4; ++m)
#pragma unroll
                for (int bj = 0; bj < 2; ++bj) g[m][bj] = *(const u32x4*)(proj + pj((size_t)(row0 + ai * 128 + m * 16), C_GL + br * 2048 + col0 + bj * 128));
#pragma unroll
            for (int m = 0; m < 4; ++m) {
                const size_t row = (size_t)(row0 + ai * 128 + m * 16);
#pragma unroll
                for (int bj = 0; bj < 2; ++bj) {
                    const int col = col0 + bj * 128;
                    const u32x4 gg = g[m][bj];
                    f32x4 v0 = acc[ai][bj][m][0], v1 = acc[ai][bj][m][1];
                    v0[0] *= bflo(gg.x); v0[1] *= bfhi(gg.x); v0[2] *= bflo(gg.y); v0[3] *= bfhi(gg.y);
                    v1[0] *= bflo(gg.z); v1[1] *= bfhi(gg.z); v1[2] *= bflo(gg.w); v1[3] *= bfhi(gg.w);
                    if (br < 3) { acc[ai][bj][m][0] = v0; acc[ai][bj][m][1] = v1; }
                    else { u32x4 w; w.x = pk2(v0[0], v0[1]); w.y = pk2(v0[2], v0[3]); w.z = pk2(v1[0], v1[1]); w.w = pk2(v1[2], v1[3]);
                        *(u32x4*)(M + row * D_ + col) = w; }
                }
            }
            asm volatile("" ::: "memory");
        }
        return br < 3;
    }
};
struct EpiU {
    bf16_t* C;
    __device__ __forceinline__ bool operator()(f32x4 (&acc)[2][2][4][2], const GUnit& u, int wr, int wc, int fr, int fq) const {
        const int row0 = u.pm * 256 + wr * 64 + fr, col0 = u.pn * 256 + wc * 32 + 8 * fq;
#pragma unroll
        for (int ai = 0; ai < 2; ++ai)
#pragma unroll
            for (int m = 0; m < 4; ++m) {
                bf16_t* rowp = C + (size_t)(row0 + ai * 128 + m * 16) * D_ + col0;
#pragma unroll
                for (int bj = 0; bj < 2; ++bj) { const f32x4 v0 = acc[ai][bj][m][0], v1 = acc[ai][bj][m][1];
                    u32x4 w; w.x = pk2(v0[0], v0[1]); w.y = pk2(v0[2], v0[3]); w.z = pk2(v1[0], v1[1]); w.w = pk2(v1[2], v1[3]); *(u32x4*)(rowp + bj * 128) = w; }
            }
        return false;
    }
};

__device__ __forceinline__ int gate_rowmap(int g) {
    const int b = g >> 11, chn = g & 2047, q = chn >> 6, ch = chn & 63;
    return q * 256 + (b >> 1) * 128 + (ch >> 4) * 32 + ((ch >> 2) & 3) * 8 + (b & 1) * 4 + (ch & 3);
}
template <bool GMAP>
__device__ __forceinline__ void transpose_item(const float* W, int src_ld, int nvalid, bf16_t* WT, int dst_ld, int dst_k0, LAS float* scr, int kb, int nb, int lane) {
    const int k0 = 64 * kb, n0 = 64 * nb;
    const int krow = lane >> 4, nq = lane & 15, fr = lane & 15, fq = lane >> 4;
    const bool ok = (n0 + 4 * nq) < nvalid;
    const float* src = W + (size_t)(k0 + krow) * src_ld + n0 + 4 * nq;
    f32x4 v[16];
#pragma unroll
    for (int i = 0; i < 16; ++i) v[i] = ok ? *(const f32x4*)(src + (size_t)(4 * i) * src_ld) : (f32x4){0.f, 0.f, 0.f, 0.f};
    LAS unsigned char* tile = (LAS unsigned char*)scr;
#pragma unroll
    for (int i = 0; i < 16; ++i) { u32x2 w; w.x = pk2(v[i].x, v[i].y); w.y = pk2(v[i].z, v[i].w); *(LAS u32x2*)(tile + (4 * i + krow) * 160 + nq * 8) = w; }
    LDS_WAIT();
    const unsigned tb = (unsigned)(uintptr_t)tile + (unsigned)((8 * fq + (fr >> 2)) * 160 + 8 * (fr & 3));
#pragma unroll
    for (int nt = 0; nt < 4; ++nt)
#pragma unroll
        for (int kh = 0; kh < 2; ++kh) {
            u32x2 a, b;
            asm volatile("ds_read_b64_tr_b16 %0, %2\n\tds_read_b64_tr_b16 %1, %2 offset:640\n\ts_waitcnt lgkmcnt(0)" : "=&v"(a), "=&v"(b) : "v"(tb + (unsigned)(kh * 32 * 160 + nt * 32)) : "memory");
            const int n = n0 + nt * 16 + fr;
            const int drow = GMAP ? gate_rowmap(n) : n;
            if (n < nvalid) *(u32x4*)(WT + (size_t)drow * dst_ld + dst_k0 + k0 + kh * 32 + 8 * fq) = (u32x4){a.x, a.y, b.x, b.y};
        }
}
template <bool GMAP = false>
__device__ __forceinline__ void cvt_job(const float* W, int src_ld, int K, int N, bf16_t* WT, int dst_ld, int dst_k0, LAS float* scr, int gw, int NGW, int lane) {
    const int nblk = (N + 63) / 64, items = (K / 64) * nblk;
    for (int it = gw; it < items; it += NGW) transpose_item<GMAP>(W, src_ld, N, WT, dst_ld, dst_k0, scr, it / nblk, it % nblk, lane);
}
__device__ __forceinline__ void cvt_win(const Params& p, int l, LAS float* scr, int gw, int NGW, int lane) {
    const float* w = p.in[5] + (size_t)l * D_ * DIN;
    bf16_t* wt = (bf16_t*)(p.ws + WS_WT_IN);
    cvt_job(w, DIN, D_, 10240, wt, D_, 0, scr, gw, NGW, lane);
    cvt_job(w + 10256, DIN, D_, 1024, wt + (size_t)10240 * D_, D_, 0, scr, (gw + NGW / 2) % NGW, NGW, lane);
    cvt_job<true>(w + 11280, DIN, D_, 8192, wt + (size_t)C_GL * D_, D_, 0, scr, (gw + NGW / 4) % NGW, NGW, lane);
}
__device__ __forceinline__ void cvt_win_item(const Params& p, int l, LAS float* scr, int id, int lane) {
    const float* w = p.in[5] + (size_t)l * D_ * DIN;
    bf16_t* wt = (bf16_t*)(p.ws + WS_WT_IN);
    const int kb = id / 304, nbg = id % 304;
    if (nbg < 160) transpose_item<false>(w, DIN, 10240, wt, D_, 0, scr, kb, nbg, lane);
    else if (nbg < 176) transpose_item<false>(w + 10256, DIN, 1024, wt + (size_t)10240 * D_, D_, 0, scr, kb, nbg - 160, lane);
    else transpose_item<true>(w + 11280, DIN, 8192, wt + (size_t)C_GL * D_, D_, 0, scr, kb, nbg - 176, lane);
}
__device__ __forceinline__ void norm_row_store(const f32x4 (&v)[8], const float* g, bf16_t* orow, int lane) {
    float ss = 0.f;
#pragma unroll
    for (int j = 0; j < 8; ++j) ss += (v[j].x * v[j].x + v[j].y * v[j].y) + (v[j].z * v[j].z + v[j].w * v[j].w);
    ss = wave_sum(ss);
    const float rs = rsqrtf(ss * (1.0f / D_) + EPS_);
    u32x2* o8 = (u32x2*)orow + lane;
#pragma unroll
    for (int j = 0; j < 8; ++j) { const f32x4 gg = *((const f32x4*)g + lane + 64 * j);
        u32x2 w; w.x = pk2(v[j].x * rs * gg.x, v[j].y * rs * gg.y); w.y = pk2(v[j].z * rs * gg.z, v[j].w * rs * gg.w); o8[64 * j] = w; }
}

__device__ __forceinline__ void phase_rows(const Params& p, LAS unsigned char* lds, int stage) {
    const int tid = opaque_tid(), lane = tid & 63, wave = tid >> 6;
    const int gw = blockIdx.x * 8 + wave, NGW = gridDim.x * 8;
    LAS float* scr = (LAS float*)(lds + wave * 10240);
    if (stage == 0) {
        cvt_win(p, 0, scr, gw, NGW, lane);
        int rot = 0;
#pragma unroll 1
        for (int l = 0; l < 2; ++l) {
            cvt_job(p.in[5] + (size_t)l * D_ * DIN + 10240, DIN, D_, 16, (bf16_t*)(p.ws + WS_WT_LR) + (size_t)l * 16 * D_, D_, 0, scr, (gw + rot) % NGW, NGW, lane); rot += 64;
#pragma unroll 1
            for (int g = 0; g < 4; ++g) { cvt_job(p.in[7] + (size_t)(l * 4 + g) * 65536, 256, 256, 256, (bf16_t*)(p.ws + WS_WT_POOL) + (size_t)(l * 4 + g) * 65536, 256, 0, scr, (gw + rot) % NGW, NGW, lane); rot += 32; }
            cvt_job(p.in[12] + (size_t)l * D_ * 1024, 1024, D_, 1024, (bf16_t*)(p.ws + WS_WT_MEMKV) + (size_t)l * 1024 * D_, D_, 0, scr, (gw + rot) % NGW, NGW, lane); rot += 1024;
            bf16_t* wbr = (bf16_t*)(p.ws + WS_WT_BR) + (size_t)l * D_ * YW;
            cvt_job(p.in[13] + (size_t)l * 1024 * D_, D_, 1024, D_, wbr, YW, 0, scr, (gw + rot) % NGW, NGW, lane); rot += 1024;
            cvt_job(p.in[14] + (size_t)l * 512 * D_, D_, 512, D_, wbr, YW, 1024, scr, (gw + rot) % NGW, NGW, lane); rot += 512;
            cvt_job(p.in[15] + (size_t)l * 1024 * D_, D_, 1024, D_, wbr, YW, 1536, scr, (gw + rot) % NGW, NGW, lane); rot += 1024;
            cvt_job(p.in[16] + (size_t)l * 512 * D_, D_, 512, D_, wbr, YW, 2560, scr, (gw + rot) % NGW, NGW, lane); rot += 512;
            cvt_job(p.in[17] + (size_t)l * D_ * D_, D_, D_, D_, (bf16_t*)(p.ws + WS_WT_OUT) + (size_t)l * D_ * D_, D_, 0, scr, (gw + rot) % NGW, NGW, lane);
        }
        for (int r = gw; r < 512; r += NGW) {
            const int l = r >> 8, m = r & 255;
            const f32x4* xr = (const f32x4*)(p.in[1] + (size_t)m * D_) + lane;
            f32x4 v[8];
#pragma unroll
            for (int j = 0; j < 8; ++j) v[j] = xr[64 * j];
            norm_row_store(v, p.in[4] + (size_t)l * D_, (bf16_t*)(p.ws + WS_MEMN) + (size_t)r * D_, lane);
        }
    }
    const bf16_t* U = (const bf16_t*)(p.ws + WS_BIG);
    bf16_t* H = (bf16_t*)(p.ws + WS_HREG);
    const float* xsrc = p.in[0];
    bf16_t* X1B = (bf16_t*)(p.ws + WS_BIG + 64 * MiB);
    f32x4 gpost[8], gpre[8];
#pragma unroll
    for (int j = 0; j < 8; ++j) { gpost[j] = (stage >= 1) ? *((const f32x4*)(p.in[3] + (size_t)(stage - 1) * D_) + lane + 64 * j) : (f32x4){0.f, 0.f, 0.f, 0.f};
        gpre[j] = (stage < 2) ? *((const f32x4*)(p.in[2] + (size_t)(stage == 0 ? 0 : 1) * D_) + lane + 64 * j) : (f32x4){0.f, 0.f, 0.f, 0.f}; }
    u32x2 ua[8], ub[8]; f32x4 xa[8], xb[8];
#define ROW_LOAD(U_, X_, r_) do { const f32x4* xr_ = (const f32x4*)(xsrc + (size_t)(r_) * D_) + lane; const u32x2* ur_ = (const u32x2*)(U + (size_t)(r_) * D_) + lane; \
        const u32x2* xb_ = (const u32x2*)(X1B + (size_t)(r_) * D_) + lane; \
        _Pragma("unroll") for (int j = 0; j < 8; ++j) { if (stage == 2) { const u32x2 w_ = xb_[64 * j]; X_[j] = (f32x4){bflo(w_.x), bfhi(w_.x), bflo(w_.y), bfhi(w_.y)}; } else X_[j] = xr_[64 * j]; \
            U_[j] = (stage >= 1) ? ur_[64 * j] : (u32x2){0u, 0u}; } } while (0)
#define ROW_PROC(U_, X_, r_) do { f32x4 v[8]; \
        if (stage == 0) { _Pragma("unroll") for (int j = 0; j < 8; ++j) v[j] = X_[j]; } \
        else { f32x4 uu[8]; float ss = 0.f; \
            _Pragma("unroll") for (int j = 0; j < 8; ++j) { uu[j] = (f32x4){bflo(U_[j].x), bfhi(U_[j].x), bflo(U_[j].y), bfhi(U_[j].y)}; ss += (uu[j].x * uu[j].x + uu[j].y * uu[j].y) + (uu[j].z * uu[j].z + uu[j].w * uu[j].w); } \
            ss = wave_sum(ss); const float rs = rsqrtf(ss * (1.0f / D_) + EPS_); \
            f32x4* orow = (f32x4*)(p.out + (size_t)(r_) * D_) + lane; u32x2* xrow = (u32x2*)(X1B + (size_t)(r_) * D_) + lane; \
            _Pragma("unroll") for (int j = 0; j < 8; ++j) { v[j] = X_[j] + uu[j] * rs * gpost[j]; \
                if (stage == 2) orow[64 * j] = v[j]; else { u32x2 w_; w_.x = pk2(v[j].x, v[j].y); w_.y = pk2(v[j].z, v[j].w); xrow[64 * j] = w_; } } } \
        if (stage < 2) { float s2 = 0.f; \
            _Pragma("unroll") for (int j = 0; j < 8; ++j) s2 += (v[j].x * v[j].x + v[j].y * v[j].y) + (v[j].z * v[j].z + v[j].w * v[j].w); \
            s2 = wave_sum(s2); const float r2 = rsqrtf(s2 * (1.0f / D_) + EPS_); \
            u32x2* o8 = (u32x2*)(H + (size_t)(r_) * D_) + lane; \
            _Pragma("unroll") for (int j = 0; j < 8; ++j) { const f32x4 hv = v[j] * r2 * gpre[j]; u32x2 w; w.x = pk2(hv.x, hv.y); w.y = pk2(hv.z, hv.w); o8[64 * j] = w; } } } while (0)
    int row = gw;
    if (row < S_) ROW_LOAD(ua, xa, row);
    while (row < S_) {
        const int n1 = row + NGW;
        if (n1 < S_) ROW_LOAD(ub, xb, n1);
        ROW_PROC(ua, xa, row);
        if (n1 >= S_) break;
        const int n2 = n1 + NGW;
        if (n2 < S_) ROW_LOAD(ua, xa, n2);
        ROW_PROC(ub, xb, n1);
        row = n2;
    }
#undef ROW_LOAD
#undef ROW_PROC
}

__device__ __forceinline__ float logsigmoidf_(float z) { return fminf(z, 0.f) - __logf(1.0f + __expf(-fabsf(z))); }
__device__ __forceinline__ void lr_gemm(const Params& p, LAS unsigned char* lds, int l) {
    const int tid = opaque_tid(), lane = tid & 63, wid = tid >> 6, fr = lane & 15, fq = lane >> 4;
    const bf16_t* H = (const bf16_t*)(p.ws + WS_HREG);
    const bf16_t* WL = (const bf16_t*)(p.ws + WS_WT_LR) + (size_t)l * 16 * D_;
    float* BC = (float*)(p.ws + WS_BC);
    LAS float* sRed = (LAS float*)lds;
    LAS float* sLR = (LAS float*)(lds + 8192);
    for (int tb = blockIdx.x; tb < 256; tb += gridDim.x) {
        lds_barrier();
        const int mt = wid & 3, kh = wid >> 2;
        const bf16_t* hrow = H + (size_t)(tb * 64 + mt * 16 + fr) * D_ + kh * 1024 + fq * 8;
        const bf16_t* wrow = WL + (size_t)fr * D_ + kh * 1024 + fq * 8;
        f32x4 acc = (f32x4){0.f, 0.f, 0.f, 0.f};
#pragma unroll 8
        for (int ks = 0; ks < 32; ++ks) { const bf16x8 a = *(const bf16x8*)(hrow + ks * 32); const bf16x8 b = *(const bf16x8*)(wrow + ks * 32); acc = mfma16(a, b, acc); }
#pragma unroll
        for (int j = 0; j < 4; ++j) sRed[(kh * 64 + mt * 16 + fq * 4 + j) * 16 + fr] = acc[j];
        float wa[16];
#pragma unroll
        for (int r = 0; r < 16; ++r) wa[r] = p.in[9][(size_t)(l * 16 + r) * 512 + tid];
        const float b = p.in[10][l * 512 + tid];
        lds_barrier();
        for (int i = tid; i < 1024; i += NTHREADS) sLR[i] = sRed[i] + sRed[1024 + i];
        lds_barrier();
        float run = 0.f;
        float* bcp = BC + (size_t)tb * 64 * 512 + tid;
#pragma unroll 4
        for (int j = 0; j < 64; ++j) { float z = b;
#pragma unroll
            for (int r4 = 0; r4 < 4; ++r4) { const f32x4 v = *(const LAS f32x4*)(sLR + j * 16 + r4 * 4); z += v.x * wa[r4 * 4] + v.y * wa[r4 * 4 + 1] + v.z * wa[r4 * 4 + 2] + v.w * wa[r4 * 4 + 3]; }
            run += logsigmoidf_(z) * (1.0f / 16.0f); bcp[(size_t)j * 512] = run; }
    }
}

__device__ __forceinline__ bf16x8 cat_frag(u32x2 lo, u32x2 hi) { const u32x4 w = (u32x4){lo.x, lo.y, hi.x, hi.y}; return __builtin_bit_cast(bf16x8, w); }
template <int HALF>
__device__ __forceinline__ bf16x8 tr2(unsigned vb) {
    u32x2 a, b;
    asm volatile("ds_read_b64_tr_b16 %0, %2\n\tds_read_b64_tr_b16 %1, %2 offset:%3\n\ts_waitcnt lgkmcnt(0)" : "=&v"(a), "=&v"(b) : "v"(vb), "i"(HALF) : "memory");
    return cat_frag(a, b);
}
template <int HALF>
__device__ __forceinline__ void tr16(unsigned vb, u32x2 (&r)[16]) {
    asm volatile(
        "ds_read_b64_tr_b16 %0, %16 offset:%17\n\tds_read_b64_tr_b16 %1, %16 offset:%18\n\t"
        "ds_read_b64_tr_b16 %2, %16 offset:%19\n\tds_read_b64_tr_b16 %3, %16 offset:%20\n\t"
        "ds_read_b64_tr_b16 %4, %16 offset:%21\n\tds_read_b64_tr_b16 %5, %16 offset:%22\n\t"
        "ds_read_b64_tr_b16 %6, %16 offset:%23\n\tds_read_b64_tr_b16 %7, %16 offset:%24\n\t"
        "ds_read_b64_tr_b16 %8, %16 offset:%25\n\tds_read_b64_tr_b16 %9, %16 offset:%26\n\t"
        "ds_read_b64_tr_b16 %10, %16 offset:%27\n\tds_read_b64_tr_b16 %11, %16 offset:%28\n\t"
        "ds_read_b64_tr_b16 %12, %16 offset:%29\n\tds_read_b64_tr_b16 %13, %16 offset:%30\n\t"
        "ds_read_b64_tr_b16 %14, %16 offset:%31\n\tds_read_b64_tr_b16 %15, %16 offset:%32\n\t"
        "s_waitcnt lgkmcnt(0)"
        : "=&v"(r[0]), "=&v"(r[1]), "=&v"(r[2]), "=&v"(r[3]), "=&v"(r[4]), "=&v"(r[5]), "=&v"(r[6]), "=&v"(r[7]),
          "=&v"(r[8]), "=&v"(r[9]), "=&v"(r[10]), "=&v"(r[11]), "=&v"(r[12]), "=&v"(r[13]), "=&v"(r[14]), "=&v"(r[15])
        : "v"(vb), "i"(0), "i"(HALF), "i"(32), "i"(HALF + 32), "i"(64), "i"(HALF + 64), "i"(96), "i"(HALF + 96),
          "i"(128), "i"(HALF + 128), "i"(160), "i"(HALF + 160), "i"(192), "i"(HALF + 192), "i"(224), "i"(HALF + 224)
        : "memory");
}

template <int MODE, int NT>
__device__ __forceinline__ void attn_item(LAS unsigned char* lds, const bf16_t* qbase, size_t qrs, const bf16_t* kbase, const bf16_t* vbase, size_t krs, bool first,
                                          float slope_dil, bf16_t* obase, size_t ors, const bf16_t* gbase, size_t grs, float* lsebase, size_t lrs) {
    const int tid = opaque_tid(), lane = tid & 63, wid = tid >> 6, fr = lane & 15, fq = lane >> 4;
    LAS bf16_t* sK = (LAS bf16_t*)lds;
    LAS bf16_t* sV = (LAS bf16_t*)(lds + 69632);
    lds_barrier();
#pragma unroll
    for (int i = 0; i < 8; ++i) { const int id = tid + 512 * i, row = id >> 4, ch = id & 15;
        u32x4 kv = (u32x4){0u, 0u, 0u, 0u}, vv = (u32x4){0u, 0u, 0u, 0u};
        if (!(first && row < 128)) { kv = *(const u32x4*)(kbase + (ptrdiff_t)row * (ptrdiff_t)krs + ch * 8); vv = *(const u32x4*)(vbase + (ptrdiff_t)row * (ptrdiff_t)krs + ch * 8); }
        *(LAS u32x4*)(sK + row * 136 + ch * 8) = kv; *(LAS u32x4*)(sV + row * 144 + ch * 8) = vv; }
    bf16x8 qf[4];
    { const bf16_t* qrow = qbase + (size_t)(16 * wid + fr) * qrs + fq * 8;
#pragma unroll
      for (int kk = 0; kk < 4; ++kk) qf[kk] = *(const bf16x8*)(qrow + kk * 32); }
    lds_barrier();
    const int T_lo = (NT == 16) ? 0 : 2 * (wid >> 1);
    f32x4 s[NT];
#pragma unroll
    for (int ti = 0; ti < NT; ++ti) { s[ti] = (f32x4){0.f, 0.f, 0.f, 0.f};
#pragma unroll
        for (int kk = 0; kk < 4; ++kk) { const bf16x8 kf = *(const LAS bf16x8*)(sK + ((T_lo + ti) * 16 + fr) * 136 + kk * 32 + fq * 8); s[ti] = mfma16(kf, qf[kk], s[ti]); } }
    const float scale2 = 0.08838834764831845f * 1.4426950408889634f;
    const float slope2 = slope_dil * 1.4426950408889634f;
    const int qi = 16 * wid + fr;
    const int dbase = qi + 128 - T_lo * 16 - 4 * fq;
    const float cb = -slope2 * (float)dbase;
    const int kmin = first ? 128 - T_lo * 16 - 4 * fq : -1000;
    float mx = -3.0e38f;
#pragma unroll
    for (int ti = 0; ti < NT; ++ti)
#pragma unroll
        for (int j = 0; j < 4; ++j) {
            float v;
            if (MODE == 1) { const int off = 16 * ti + j;
                const bool valid = ((unsigned)(dbase - off) <= 128u) && (off >= kmin);
                v = valid ? fmaf(s[ti][j], scale2, fmaf(slope2, (float)off, cb)) : NEG_; }
            else v = s[ti][j] * scale2;
            s[ti][j] = v; mx = fmaxf(mx, v);
        }
    mx = fmaxf(mx, __shfl_xor(mx, 16)); mx = fmaxf(mx, __shfl_xor(mx, 32));
    float sm = 0.f;
#pragma unroll
    for (int ti = 0; ti < NT; ++ti)
#pragma unroll
        for (int j = 0; j < 4; ++j) { const float e = __builtin_amdgcn_exp2f(s[ti][j] - mx); s[ti][j] = e; sm += e; }
    sm += __shfl_xor(sm, 16); sm += __shfl_xor(sm, 32);
    const float inv = 1.0f / sm;
    bf16x8 pf[NT / 2];
#pragma unroll
    for (int ks = 0; ks < NT / 2; ++ks) { u32x4 w; w.x = pk2(s[2 * ks][0] * inv, s[2 * ks][1] * inv); w.y = pk2(s[2 * ks][2] * inv, s[2 * ks][3] * inv);
        w.z = pk2(s[2 * ks + 1][0] * inv, s[2 * ks + 1][1] * inv); w.w = pk2(s[2 * ks + 1][2] * inv, s[2 * ks + 1][3] * inv); pf[ks] = __builtin_bit_cast(bf16x8, w); }
    f32x4 o[8];
#pragma unroll
    for (int dt = 0; dt < 8; ++dt) o[dt] = (f32x4){0.f, 0.f, 0.f, 0.f};
    const unsigned vb0 = (unsigned)(uintptr_t)sV + (unsigned)(((T_lo * 16 + 4 * fq + (fr >> 2)) * 144 + 4 * (fr & 3)) * 2);
#pragma unroll
    for (int ks = 0; ks < NT / 2; ++ks) {
        u32x2 r[16];
        const unsigned vb = vb0 + (unsigned)(ks * 9216);
        tr16<4608>(vb, r);
#pragma unroll
        for (int dt = 0; dt < 8; ++dt) o[dt] = mfma16(cat_frag(r[2 * dt], r[2 * dt + 1]), pf[ks], o[dt]);
    }
    const size_t i = (size_t)qi;
#pragma unroll
    for (int dt = 0; dt < 8; ++dt) { const int d = dt * 16 + 4 * fq; f32x4 val = o[dt];
        if (MODE == 0) { const u32x2 g = *(const u32x2*)(gbase + i * grs + d); val[0] *= bflo(g.x); val[1] *= bfhi(g.x); val[2] *= bflo(g.y); val[3] *= bfhi(g.y); }
        u32x2 w; w.x = pk2(val[0], val[1]); w.y = pk2(val[2], val[3]); *(u32x2*)(obase + i * ors + d) = w; }
    if (MODE == 1) { if (fq == 0) lsebase[i * lrs] = (mx + __builtin_amdgcn_logf(sm)) * 0.6931471805599453f; }
}

__device__ __forceinline__ void gla_kv_item(const Params& p, LAS unsigned char* lds, int l, int item) {
    const int tid = opaque_tid(), lane = tid & 63, wid = tid >> 6, fr = lane & 15, fq = lane >> 4;
    const int c = item >> 2, h = item & 3;
    LAS bf16_t* sKs = (LAS bf16_t*)lds;
    LAS bf16_t* sV = (LAS bf16_t*)(lds + 18432);
    const bf16_t* prow = (const bf16_t*)(p.ws + WS_PROJ) + (size_t)(c * 64) * PRS;
    const float* bcc = (const float*)(p.ws + WS_BC) + (size_t)(c * 64) * 512 + h * 128;
    lds_barrier();
#pragma unroll
    for (int i = 0; i < 2; ++i) { const int id = tid + 512 * i, j = id >> 4, ch = id & 15;
        const u32x4 kv = *(const u32x4*)(prow + pj((size_t)j, C_CK + h * 128 + ch * 8));
        const f32x4 b0 = *(const f32x4*)(bcc + (size_t)j * 512 + ch * 8), b1 = *(const f32x4*)(bcc + (size_t)j * 512 + ch * 8 + 4);
        const f32x4 l0 = *(const f32x4*)(bcc + (size_t)63 * 512 + ch * 8), l1 = *(const f32x4*)(bcc + (size_t)63 * 512 + ch * 8 + 4);
        u32x4 o;
        o.x = pk2(bflo(kv.x) * __expf(l0.x - b0.x), bfhi(kv.x) * __expf(l0.y - b0.y)); o.y = pk2(bflo(kv.y) * __expf(l0.z - b0.z), bfhi(kv.y) * __expf(l0.w - b0.w));
        o.z = pk2(bflo(kv.z) * __expf(l1.x - b1.x), bfhi(kv.z) * __expf(l1.y - b1.y)); o.w = pk2(bflo(kv.w) * __expf(l1.z - b1.z), bfhi(kv.w) * __expf(l1.w - b1.w));
        *(LAS u32x4*)(sKs + j * 144 + ch * 8) = o; }
#pragma unroll
    for (int i = 0; i < 4; ++i) { const int id = tid + 512 * i, j = id >> 5, ch = id & 31;
        *(LAS u32x4*)(sV + j * 272 + ch * 8) = *(const u32x4*)(prow + pj((size_t)j, C_CV + h * 256 + ch * 8)); }
    if (tid < 128) ((float*)(p.ws + WS_DEC))[(size_t)item * 128 + tid] = __expf(bcc[(size_t)63 * 512 + tid]);
    lds_barrier();
    f32x4 acc[8][2];
#pragma unroll
    for (int m = 0; m < 8; ++m) { acc[m][0] = (f32x4){0.f, 0.f, 0.f, 0.f}; acc[m][1] = (f32x4){0.f, 0.f, 0.f, 0.f}; }
    const unsigned kb0 = (unsigned)(uintptr_t)sKs + (unsigned)(((4 * fq + (fr >> 2)) * 144 + 4 * (fr & 3)) * 2);
    const unsigned vb0 = (unsigned)(uintptr_t)sV + (unsigned)(((4 * fq + (fr >> 2)) * 272 + 4 * (fr & 3)) * 2) + (unsigned)(wid * 64);
#pragma unroll
    for (int ks = 0; ks < 2; ++ks) {
        u32x2 r[16];
        tr16<4608>(kb0 + (unsigned)(ks * 32 * 288), r);
        const bf16x8 v0 = tr2<8704>(vb0 + (unsigned)(ks * 32 * 544)), v1 = tr2<8704>(vb0 + (unsigned)(ks * 32 * 544) + 32u);
#pragma unroll
        for (int m = 0; m < 8; ++m) { const bf16x8 kf = cat_frag(r[2 * m], r[2 * m + 1]); acc[m][0] = mfma16(kf, v0, acc[m][0]); acc[m][1] = mfma16(kf, v1, acc[m][1]); }
    }
    bf16_t* KV = (bf16_t*)(p.ws + WS_BIG) + (size_t)item * 32768;
#pragma unroll
    for (int n = 0; n < 2; ++n)
#pragma unroll
        for (int m = 0; m < 8; ++m) { u32x2 w; w.x = pk2(acc[m][n][0], acc[m][n][1]); w.y = pk2(acc[m][n][2], acc[m][n][3]);
            *(u32x2*)(KV + (size_t)((2 * wid + n) * 16 + fr) * 128 + m * 16 + 4 * fq) = w; }
}
__device__ __forceinline__ void gla_out_item(const Params& p, LAS unsigned char* lds, int l, int item) {
    const int tid = opaque_tid(), lane = tid & 63, wid = tid >> 6, fr = lane & 15, fq = lane >> 4;
    const int c = item >> 2, h = item & 3;
    LAS bf16_t* sQ = (LAS bf16_t*)lds;
    LAS bf16_t* sK2 = (LAS bf16_t*)(lds + 17408);
    LAS bf16_t* sV = (LAS bf16_t*)(lds + 34816);
    LAS float* sSS = (LAS float*)(lds + 69632);
    const bf16_t* PROJ = (const bf16_t*)(p.ws + WS_PROJ);
    const bf16_t* prow = PROJ + (size_t)(c * 64) * PRS;
    const float* bcc = (const float*)(p.ws + WS_BC) + (size_t)(c * 64) * 512 + h * 128;
    lds_barrier();
#pragma unroll
    for (int i = 0; i < 2; ++i) { const int id = tid + 512 * i, row = id >> 4, ch = id & 15;
        const u32x4 q8 = *(const u32x4*)(prow + pj((size_t)row, C_CQ + h * 128 + ch * 8));
        const u32x4 k8 = *(const u32x4*)(prow + pj((size_t)row, C_CK + h * 128 + ch * 8));
        const f32x4 b0 = *(const f32x4*)(bcc + (size_t)row * 512 + ch * 8), b1 = *(const f32x4*)(bcc + (size_t)row * 512 + ch * 8 + 4);
        const float sc = 0.08838834764831845f;
        u32x4 qo, ko;
        qo.x = pk2(bflo(q8.x) * sc * __expf(b0.x), bfhi(q8.x) * sc * __expf(b0.y)); qo.y = pk2(bflo(q8.y) * sc * __expf(b0.z), bfhi(q8.y) * sc * __expf(b0.w));
        qo.z = pk2(bflo(q8.z) * sc * __expf(b1.x), bfhi(q8.z) * sc * __expf(b1.y)); qo.w = pk2(bflo(q8.w) * sc * __expf(b1.z), bfhi(q8.w) * sc * __expf(b1.w));
        ko.x = pk2(bflo(k8.x) * __expf(-b0.x), bfhi(k8.x) * __expf(-b0.y)); ko.y = pk2(bflo(k8.y) * __expf(-b0.z), bfhi(k8.y) * __expf(-b0.w));
        ko.z = pk2(bflo(k8.z) * __expf(-b1.x), bfhi(k8.z) * __expf(-b1.y)); ko.w = pk2(bflo(k8.w) * __expf(-b1.z), bfhi(k8.w) * __expf(-b1.w));
        *(LAS u32x4*)(sQ + row * 136 + ch * 8) = qo; *(LAS u32x4*)(sK2 + row * 136 + ch * 8) = ko; }
#pragma unroll
    for (int i = 0; i < 4; ++i) { const int id = tid + 512 * i, j = id >> 5, ch = id & 31;
        *(LAS u32x4*)(sV + j * 272 + ch * 8) = *(const u32x4*)(prow + pj((size_t)j, C_CV + h * 256 + ch * 8)); }
    lds_barrier();
    const int it = wid & 3, nh = wid >> 2;
    bf16x8 qf[4];
#pragma unroll
    for (int kk = 0; kk < 4; ++kk) qf[kk] = *(const LAS bf16x8*)(sQ + (it * 16 + fr) * 136 + kk * 32 + fq * 8);
    bf16x8 pa[2];
    {
        f32x4 at[4];
#pragma unroll
        for (int jt = 0; jt < 4; ++jt) { at[jt] = (f32x4){0.f, 0.f, 0.f, 0.f};
#pragma unroll
            for (int kk = 0; kk < 4; ++kk) { const bf16x8 kf = *(const LAS bf16x8*)(sK2 + (jt * 16 + fr) * 136 + kk * 32 + fq * 8); at[jt] = mfma16(kf, qf[kk], at[jt]); }
#pragma unroll
            for (int jj = 0; jj < 4; ++jj) { const int j = jt * 16 + 4 * fq + jj, i = it * 16 + fr; at[jt][jj] = (j <= i) ? at[jt][jj] : 0.f; } }
#pragma unroll
        for (int ks = 0; ks < 2; ++ks) { u32x4 w; w.x = pk2(at[2 * ks][0], at[2 * ks][1]); w.y = pk2(at[2 * ks][2], at[2 * ks][3]);
            w.z = pk2(at[2 * ks + 1][0], at[2 * ks + 1][1]); w.w = pk2(at[2 * ks + 1][2], at[2 * ks + 1][3]); pa[ks] = __builtin_bit_cast(bf16x8, w); }
    }
    f32x4 o[8];
#pragma unroll
    for (int n8 = 0; n8 < 8; ++n8) o[n8] = (f32x4){0.f, 0.f, 0.f, 0.f};
    const unsigned vb0 = (unsigned)(uintptr_t)sV + (unsigned)(((4 * fq + (fr >> 2)) * 272 + 4 * (fr & 3)) * 2) + (unsigned)(nh * 256);
#pragma unroll
    for (int ks = 0; ks < 2; ++ks) {
        u32x2 r[16];
        tr16<8704>(vb0 + (unsigned)(ks * 32 * 544), r);
#pragma unroll
        for (int n8 = 0; n8 < 8; ++n8) o[n8] = mfma16(cat_frag(r[2 * n8], r[2 * n8 + 1]), pa[ks], o[n8]);
    }
    {
        const bf16_t* sp = (const bf16_t*)(p.ws + WS_SP) + (size_t)item * 32768 + (size_t)((nh * 8) * 16 + fr) * 128 + fq * 8;
#pragma unroll
        for (int n8 = 0; n8 < 8; ++n8)
#pragma unroll
            for (int kk = 0; kk < 4; ++kk) { const bf16x8 sf = *(const bf16x8*)(sp + (size_t)n8 * 16 * 128 + kk * 32); o[n8] = mfma16(sf, qf[kk], o[n8]); }
    }
    float a = 0.f;
#pragma unroll
    for (int n8 = 0; n8 < 8; ++n8) a += (o[n8][0] * o[n8][0] + o[n8][1] * o[n8][1]) + (o[n8][2] * o[n8][2] + o[n8][3] * o[n8][3]);
    a += __shfl_xor(a, 16); a += __shfl_xor(a, 32);
    if (fq == 0) sSS[nh * 64 + it * 16 + fr] = a;
    lds_barrier();
    const int i = it * 16 + fr;
    const float rstd = rsqrtf((sSS[i] + sSS[64 + i]) * (1.0f / 256.0f) + EPS_);
    const size_t t = (size_t)c * 64 + i;
    bf16_t* yrow = (bf16_t*)(p.ws + WS_Y) + t * YW + Y_GLA + h * 256;
    const bf16_t* grow = PROJ + pj(t, C_CGATE + h * 256);
    const float* gg = p.in[11] + (size_t)l * 1024 + h * 256;
#pragma unroll
    for (int n8 = 0; n8 < 8; ++n8) { const int vd = (nh * 8 + n8) * 16 + 4 * fq;
        const f32x4 g4 = *(const f32x4*)(gg + vd); const u32x2 gt = *(const u32x2*)(grow + vd);
        u32x2 w; w.x = pk2(o[n8][0] * rstd * g4.x * bflo(gt.x), o[n8][1] * rstd * g4.y * bfhi(gt.x)); w.y = pk2(o[n8][2] * rstd * g4.z * bflo(gt.y), o[n8][3] * rstd * g4.w * bfhi(gt.y));
        *(u32x2*)(yrow + vd) = w; }
}

__device__ __forceinline__ void memkv_item(const Params& p, int item) {
    const int tid = opaque_tid(), lane = tid & 63, wid = tid >> 6, fr = lane & 15, fq = lane >> 4;
    const int l = item >> 6, nt = item & 63;
    const bf16_t* A = (const bf16_t*)(p.ws + WS_MEMN) + (size_t)l * 256 * D_ + (size_t)(wid * 32 + fr) * D_ + fq * 8;
    const bf16_t* B = (const bf16_t*)(p.ws + WS_WT_MEMKV) + (size_t)l * 1024 * D_ + (size_t)(nt * 16 + fr) * D_ + fq * 8;
    f32x4 a0 = (f32x4){0.f, 0.f, 0.f, 0.f}, a1 = (f32x4){0.f, 0.f, 0.f, 0.f};
#pragma unroll 8
    for (int ks = 0; ks < 64; ++ks) { const bf16x8 b = *(const bf16x8*)(B + ks * 32);
        a0 = mfma16(*(const bf16x8*)(A + ks * 32), b, a0); a1 = mfma16(*(const bf16x8*)(A + (size_t)16 * D_ + ks * 32), b, a1); }
    bf16_t* O = (bf16_t*)(p.ws + WS_MEMKV) + (size_t)l * 256 * 1024 + nt * 16 + fr;
#pragma unroll
    for (int j = 0; j < 4; ++j) { O[(size_t)(wid * 32 + fq * 4 + j) * 1024] = (bf16_t)f2bf(a0[j]); O[(size_t)(wid * 32 + 16 + fq * 4 + j) * 1024] = (bf16_t)f2bf(a1[j]); }
}

template <int W>
__device__ __forceinline__ void pool_item(const Params& p, LAS unsigned char* lds, int l, int n, int g) {
    const int tid = opaque_tid(), lane = tid & 63, wid = tid >> 6, fr = lane & 15, fq = lane >> 4;
    LAS bf16_t* sA = (LAS bf16_t*)lds;
    LAS bf16_t* sB = (LAS bf16_t*)(lds + 67584);
    const bf16_t* PROJ = (const bf16_t*)(p.ws + WS_PROJ);
    const bf16_t* WP = (const bf16_t*)(p.ws + WS_WT_POOL) + (size_t)(l * 4 + g) * 65536;
    lds_barrier();
#pragma unroll
    for (int i = 0; i < 8; ++i) { const int id = tid + 512 * i, row = id >> 5, ch = id & 31;
        *(LAS u32x4*)(sB + row * 264 + ch * 8) = *(const u32x4*)(WP + (size_t)row * 256 + ch * 8); }
    {
        const int ch = tid & 31, run = tid >> 5, t0 = n * 128 + run * 8;
        const bf16_t* up = PROJ + pj((size_t)t0, C_AVAL + g * 256 + ch * 8);
        float a[8] = {0.f, 0.f, 0.f, 0.f, 0.f, 0.f, 0.f, 0.f};
#pragma unroll
        for (int j = 1; j < W; ++j) if (t0 - j >= 0) { const u32x4 v = *(const u32x4*)(up - (ptrdiff_t)j * PRS);
            a[0] += bflo(v.x); a[1] += bfhi(v.x); a[2] += bflo(v.y); a[3] += bfhi(v.y); a[4] += bflo(v.z); a[5] += bfhi(v.z); a[6] += bflo(v.w); a[7] += bfhi(v.w); }
#pragma unroll
        for (int sidx = 0; sidx < 8; ++sidx) { const int t = t0 + sidx;
            const u32x4 v = *(const u32x4*)(up + (ptrdiff_t)sidx * PRS);
            const float x[8] = {bflo(v.x), bfhi(v.x), bflo(v.y), bfhi(v.y), bflo(v.z), bfhi(v.z), bflo(v.w), bfhi(v.w)};
#pragma unroll
            for (int e = 0; e < 8; ++e) a[e] += x[e];
            const float ic = 1.0f / (float)((t + 1 < W) ? t + 1 : W);
            u32x4 o; o.x = pk2(a[0] * ic - x[0], a[1] * ic - x[1]); o.y = pk2(a[2] * ic - x[2], a[3] * ic - x[3]);
            o.z = pk2(a[4] * ic - x[4], a[5] * ic - x[5]); o.w = pk2(a[6] * ic - x[6], a[7] * ic - x[7]);
            *(LAS u32x4*)(sA + (run * 8 + sidx) * 264 + ch * 8) = o;
            if (t - W + 1 >= 0) { const u32x4 q = *(const u32x4*)(up + (ptrdiff_t)(sidx - W + 1) * PRS);
                a[0] -= bflo(q.x); a[1] -= bfhi(q.x); a[2] -= bflo(q.y); a[3] -= bfhi(q.y); a[4] -= bflo(q.z); a[5] -= bfhi(q.z); a[6] -= bflo(q.w); a[7] -= bfhi(q.w); }
        }
    }
    lds_barrier();
    bf16x8 af[8];
#pragma unroll
    for (int ks = 0; ks < 8; ++ks) af[ks] = *(const LAS bf16x8*)(sA + (16 * wid + fr) * 264 + ks * 32 + fq * 8);
    const size_t t = (size_t)n * 128 + 16 * wid + fr;
    bf16_t* yrow = (bf16_t*)(p.ws + WS_Y) + t * YW + Y_POOL + g * 256;
    const bf16_t* grow = PROJ + pj(t, C_AGATE + g * 256);
    const float* sc = p.in[8] + (size_t)l * 1024 + g * 256;
#pragma unroll
    for (int half = 0; half < 2; ++half) {
        if (half == 1) {
            lds_barrier();
#pragma unroll
            for (int i = 0; i < 8; ++i) { const int id = tid + 512 * i, row = id >> 5, ch = id & 31;
                *(LAS u32x4*)(sB + row * 264 + ch * 8) = *(const u32x4*)(WP + (size_t)(128 + row) * 256 + ch * 8); }
            lds_barrier();
        }
#pragma unroll
        for (int nt = 0; nt < 8; ++nt) {
            f32x4 acc = (f32x4){0.f, 0.f, 0.f, 0.f};
#pragma unroll
            for (int ks = 0; ks < 8; ++ks) { const bf16x8 bf = *(const LAS bf16x8*)(sB + (nt * 16 + fr) * 264 + ks * 32 + fq * 8); acc = mfma16(bf, af[ks], acc); }
            const int d = half * 128 + nt * 16 + 4 * fq;
            const f32x4 s4 = *(const f32x4*)(sc + d); const u32x2 gt = *(const u32x2*)(grow + d);
            u32x2 w; w.x = pk2(acc[0] * s4.x * bflo(gt.x), acc[1] * s4.y * bfhi(gt.x)); w.y = pk2(acc[2] * s4.z * bflo(gt.y), acc[3] * s4.w * bfhi(gt.y));
            *(u32x2*)(yrow + d) = w;
        }
    }
}

#define XB_TMO      128
#define XB_XCNT(j)  (256  + 64 * (j))
#define XB_XSUB(j)  (1280 + 64 * (j))
#define XB_XGEN(j)  (2304 + 64 * (j))
#define XB_TOP      3328
#define XB_TOPGEN   3392
#define XCD_BAR_WORDS 3456
#define XB_SPIN_CAP (1u << 18)
__device__ __forceinline__ unsigned xb_ld(unsigned* p)              { return __hip_atomic_load(p, __ATOMIC_RELAXED, __HIP_MEMORY_SCOPE_AGENT); }
__device__ __forceinline__ unsigned xb_add(unsigned* p, unsigned v) { return __hip_atomic_fetch_add(p, v, __ATOMIC_RELAXED, __HIP_MEMORY_SCOPE_AGENT); }
__device__ __forceinline__ unsigned xb_xcc_id() { return (unsigned)__builtin_amdgcn_s_getreg((3 << 11) | 20) & 0xFu; }
#define XB_SPIN(cond, bar) do { unsigned _sp = 0; while (cond) { __builtin_amdgcn_s_sleep(1); \
    if ((++_sp & 255u) == 0u) { if (xb_ld(&(bar)[XB_TMO])) break; if (_sp > XB_SPIN_CAP) { atomicAdd(&(bar)[XB_TMO], 1u); break; } } } } while (0)
struct XcdBarrier { unsigned* bar; unsigned x; volatile LAS unsigned* st; };
__device__ __forceinline__ XcdBarrier xcd_barrier_post(unsigned* bar, volatile LAS unsigned* st) {
    XcdBarrier b; b.bar = bar; b.x = xb_xcc_id(); b.st = st;
    if (threadIdx.x == 0) (void)xb_add(&bar[XB_XCNT(b.x)], 1u);
    return b;
}
__device__ __forceinline__ void xcd_barrier_complete(unsigned* bar, unsigned x, unsigned& nloc, unsigned& nx) {
    const unsigned G = gridDim.x * gridDim.y * gridDim.z;
    unsigned sum, cnt, mine, sp = 0u;
    for (;;) {
        sum = 0u; cnt = 0u; mine = 0u;
#pragma unroll
        for (unsigned j = 0; j < 16; ++j) { const unsigned c = xb_ld(&bar[XB_XCNT(j)]); sum += c; cnt += (c > 0u) ? 1u : 0u; mine = (j == x) ? c : mine; }
        if (sum == G) break;
        __builtin_amdgcn_s_sleep(1);
        if ((++sp & 255u) == 0u) { if (xb_ld(&bar[XB_TMO])) break; if (sp > XB_SPIN_CAP) { atomicAdd(&bar[XB_TMO], 1u); break; } }
    }
    nloc = mine > 0u ? mine : 1u; nx = cnt > 0u ? cnt : 1u;
}
__device__ __forceinline__ void xcd_barrier(const XcdBarrier& b) {
    asm volatile("s_waitcnt vmcnt(0)" ::: "memory");
    __syncthreads();
    if (threadIdx.x == 0) {
        unsigned* bar = b.bar;
        __builtin_amdgcn_s_waitcnt(0);
        unsigned nloc = b.st[0], nx = b.st[1];
        if (nloc == 0u) { xcd_barrier_complete(bar, b.x, nloc, nx); b.st[0] = nloc; b.st[1] = nx; }
        const unsigned old = xb_add(&bar[XB_XSUB(b.x)], 1u);
        const unsigned gen = old / nloc;
        if (old + 1u == (gen + 1u) * nloc) {
            __builtin_amdgcn_fence(__ATOMIC_RELEASE, "agent");
            asm volatile("s_waitcnt vmcnt(0)" ::: "memory");
            const unsigned og = xb_add(&bar[XB_TOP], 1u);
            const unsigned tg = og / nx;
            if (og + 1u == (tg + 1u) * nx) xb_add(&bar[XB_TOPGEN], 1u);
            else XB_SPIN(xb_ld(&bar[XB_TOPGEN]) == tg, bar);
            __builtin_amdgcn_fence(__ATOMIC_ACQUIRE, "agent");
            xb_add(&bar[XB_XGEN(b.x)], 1u);
            asm volatile("s_waitcnt vmcnt(0)" ::: "memory");
        } else {
            XB_SPIN(xb_ld(&bar[XB_XGEN(b.x)]) == gen, bar);
            __builtin_amdgcn_fence(__ATOMIC_ACQUIRE, "agent");
            asm volatile("s_waitcnt vmcnt(0)" ::: "memory");
        }
    }
    __syncthreads();
}

__global__ void __launch_bounds__(512, 2) fwd_megakernel(Params p) {
    extern __shared__ __attribute__((aligned(16))) unsigned char lds_raw[];
    LAS unsigned char* lds = (LAS unsigned char*)lds_raw;
    cg::grid_group grid = cg::this_grid();
    const int G = gridDim.x, bx = blockIdx.x;
    const int vcu = (G % 8 == 0) ? (bx % 8) * (G / 8) + bx / 8 : bx;
    bf16_t* PROJ = (bf16_t*)(p.ws + WS_PROJ);
    bf16_t* Y = (bf16_t*)(p.ws + WS_Y);

    {
        if (threadIdx.x < 4) ((LAS unsigned*)(lds + LDS_BYTES - 16))[threadIdx.x] = 0u;
        __syncthreads();
    }
    const XcdBarrier xbar = xcd_barrier_post((unsigned*)(p.ws + WS_CTL), (volatile LAS unsigned*)(lds + LDS_BYTES - 16));
    for (int rep = 0; rep < NREP(1); ++rep) phase_rows(p, lds, 0);
    xcd_barrier(xbar);
    if (p.out == nullptr) grid.sync();

#pragma unroll 1
    for (int l = 0; l < 2; ++l) {
        for (int rep = 0; rep < NREP(2); ++rep) {
            __syncthreads();
            SchedProj sch{(const char*)(p.ws + WS_HREG), (const char*)(p.ws + WS_WT_IN), G, bx};
            EpiBf16 epi{PROJ, NP, p.in[6] + (size_t)l * 8192, 0};
            gemm_phase(lds, D_, D_, sch, epi);
            lr_gemm(p, lds, l);
        }
        GSYNC();
        for (int rep = 0; rep < NREP(4); ++rep) {
            if (l == 0) for (int it = G - 1 - bx; it < 128; it += G) memkv_item(p, it);
            {
                unsigned* qhead = (unsigned*)(p.ws + WS_CTL) + 4096 + ((0 * 2 + l) * 8 + (bx & 7)) * 64;
                LAS int* sq = (LAS int*)(lds + LDS_BYTES - 32);
                const int xbase = (bx & 7) * (G / 8);
                for (;;) {
                    if (threadIdx.x == 0) *sq = (int)__hip_atomic_fetch_add(qhead, 1u, __ATOMIC_RELAXED, __HIP_MEMORY_SCOPE_AGENT);
                    lds_barrier();
                    const int q = *sq;
                    if (q >= 320) break;
                    if (q < 192) {
                        const int it = xbase + (q & 31) + 256 * (q >> 5);
                        const int g = it >> 9, x = it & 511, hs = x & 3, y = x >> 2;
                        const int dil = (g == 0) ? 1 : (g == 1 ? 4 : 16);
                        const int n = y / dil, r = y % dil;
                        const int h12 = g * 4 + hs;
                        const float slope = exp2f(-8.0f * (float)(h12 + 1) / 12.0f);
                        const size_t t0 = (size_t)n * 128 * dil + r;
                        const bf16_t* qb = PROJ + pj(t0, C_SQ + h12 * 128);
                        const bf16_t* kb = PROJ + pj(0, C_SK + h12 * 128) + (ptrdiff_t)((ptrdiff_t)t0 - (ptrdiff_t)128 * dil) * PRS;
                        const bf16_t* vb = PROJ + pj(0, C_SV + h12 * 128) + (ptrdiff_t)((ptrdiff_t)t0 - (ptrdiff_t)128 * dil) * PRS;
                        bf16_t* ob = (bf16_t*)(p.ws + WS_SWAO) + ((size_t)g * S_ + t0) * 512 + hs * 128;
                        float* lb = (float*)(p.ws + WS_LSE) + ((size_t)g * S_ + t0) * 4 + hs;
                        attn_item<1, 10>(lds, qb, (size_t)dil * PRS, kb, vb, (size_t)dil * PRS, n == 0, slope * (float)dil, ob, (size_t)dil * 512, nullptr, 0, lb, (size_t)dil * 4);
                    } else {
                        const int q2 = q - 192;
                        gla_kv_item(p, lds, l, xbase + (q2 & 31) + 256 * (q2 >> 5));
                    }
                }
            }
        }
        GSYNC();
        for (int rep = 0; rep < NREP(8); ++rep) {
            const int tid = opaque_tid();
            const int wvD = __builtin_amdgcn_readfirstlane(tid >> 6);
            __syncthreads();
            if (tid == 0) *(LAS int*)(lds + 90112) = 0;
            __syncthreads();
            if (wvD < 4) {
                const bf16_t* KV = (const bf16_t*)(p.ws + WS_BIG); const float* DEC = (const float*)(p.ws + WS_DEC); bf16_t* SP = (bf16_t*)(p.ws + WS_SP);
                for (int rep2 = 0; rep2 < NREP(0x800); ++rep2) for (size_t e2 = (size_t)bx * 256 + tid; e2 < 65536; e2 += (size_t)G * 256) {
                    const int h = (int)(e2 >> 14), rest = (int)(e2 & 16383) * 2, kd = rest & 127;
                    float st0 = 0.f, st1 = 0.f;
#pragma unroll 1
                    for (int c0 = 0; c0 < 256; c0 += 32) {
                        unsigned kvv[32]; f32x2 dd[32];
#pragma unroll
                        for (int i = 0; i < 32; ++i) { const int c = c0 + i;
                            kvv[i] = *(const unsigned*)(KV + (size_t)(c * 4 + h) * 32768 + rest);
                            dd[i] = *(const f32x2*)(DEC + (c * 4 + h) * 128 + kd); }
#pragma unroll
                        for (int i = 0; i < 32; ++i) { const int c = c0 + i;
                            *(unsigned*)(SP + (size_t)(c * 4 + h) * 32768 + rest) = pk2(st0, st1);
                            st0 = dd[i].x * st0 + bflo(kvv[i]); st1 = dd[i].y * st1 + bfhi(kvv[i]); }
                    }
                }
            } else {
                const bf16_t* SO = (const bf16_t*)(p.ws + WS_SWAO); const float* LSE = (const float*)(p.ws + WS_LSE);
                for (size_t w = (size_t)bx * 256 + (tid - 256); w < (size_t)S_ * 64; w += (size_t)G * 256) {
                    const size_t t = w >> 6; const int hs = (int)(w >> 4) & 3, d8 = (int)(w & 15) * 8;
                    const float l0 = LSE[(0 * (size_t)S_ + t) * 4 + hs], l1 = LSE[(1 * (size_t)S_ + t) * 4 + hs], l2 = LSE[(2 * (size_t)S_ + t) * 4 + hs];
                    const float m = fmaxf(l0, fmaxf(l1, l2));
                    float e0 = __expf(l0 - m), e1 = __expf(l1 - m), e2 = __expf(l2 - m);
                    const float is = 1.0f / (e0 + e1 + e2); e0 *= is; e1 *= is; e2 *= is;
                    const u32x4 a = *(const u32x4*)(SO + (0 * (size_t)S_ + t) * 512 + hs * 128 + d8);
                    const u32x4 b = *(const u32x4*)(SO + (1 * (size_t)S_ + t) * 512 + hs * 128 + d8);
                    const u32x4 c = *(const u32x4*)(SO + (2 * (size_t)S_ + t) * 512 + hs * 128 + d8);
                    const u32x4 g = *(const u32x4*)(PROJ + pj(t, C_SGATE + hs * 128 + d8));
                    u32x4 o;
                    o.x = pk2((e0 * bflo(a.x) + e1 * bflo(b.x) + e2 * bflo(c.x)) * bflo(g.x), (e0 * bfhi(a.x) + e1 * bfhi(b.x) + e2 * bfhi(c.x)) * bfhi(g.x));
                    o.y = pk2((e0 * bflo(a.y) + e1 * bflo(b.y) + e2 * bflo(c.y)) * bflo(g.y), (e0 * bfhi(a.y) + e1 * bfhi(b.y) + e2 * bfhi(c.y)) * bfhi(g.y));
                    o.z = pk2((e0 * bflo(a.z) + e1 * bflo(b.z) + e2 * bflo(c.z)) * bflo(g.z), (e0 * bfhi(a.z) + e1 * bfhi(b.z) + e2 * bfhi(c.z)) * bfhi(g.z));
                    o.w = pk2((e0 * bflo(a.w) + e1 * bflo(b.w) + e2 * bflo(c.w)) * bflo(g.w), (e0 * bfhi(a.w) + e1 * bfhi(b.w) + e2 * bfhi(c.w)) * bfhi(g.w));
                    *(u32x4*)(Y + t * YW + Y_SWA + hs * 128 + d8) = o;
                }
            }
            if (l == 0) {
                LAS int* ctr = (LAS int*)(lds + 90112);
                for (;;) {
                    int idx = 0; if ((tid & 63) == 0) idx = __hip_atomic_fetch_add(ctr, 1, __ATOMIC_RELAXED, __HIP_MEMORY_SCOPE_WORKGROUP);
                    idx = __builtin_amdgcn_readfirstlane(idx);
                    const int id = bx + G * idx; if (id >= 9728) break;
                    cvt_win_item(p, 1, (LAS float*)(lds + wvD * 10240), id, tid & 63);
                }
            }
            __syncthreads();
            {
                unsigned* qhead = (unsigned*)(p.ws + WS_CTL) + 4096 + ((1 * 2 + l) * 8 + (bx & 7)) * 64;
                LAS int* sq = (LAS int*)(lds + LDS_BYTES - 32);
                const int xbase = (bx & 7) * (G / 8);
                for (;;) {
                    if (threadIdx.x == 0) *sq = (int)__hip_atomic_fetch_add(qhead, 1u, __ATOMIC_RELAXED, __HIP_MEMORY_SCOPE_AGENT);
                    lds_barrier();
                    const int q = *sq;
                    if (q >= 128) break;
                    const int q2 = q & 63, it = xbase + (q2 & 31) + 256 * (q2 >> 5);
                    if (q < 64) {
                        const int n = it >> 2, g = it & 3;
                        if (g == 0) pool_item<2>(p, lds, l, n, 0); else if (g == 1) pool_item<4>(p, lds, l, n, 1); else if (g == 2) pool_item<8>(p, lds, l, n, 2); else pool_item<16>(p, lds, l, n, 3);
                    } else {
                        const int n = it >> 2, h = it & 3;
                        const size_t t0 = (size_t)n * 128;
                        const bf16_t* mk = (const bf16_t*)(p.ws + WS_MEMKV) + (size_t)l * 256 * 1024;
                        attn_item<0, 16>(lds, PROJ + pj(t0, C_MQ + h * 128), PRS, mk + h * 128, mk + 512 + h * 128, 1024, false, 0.f,
                                     Y + t0 * YW + Y_MEM + h * 128, YW, PROJ + pj(t0, C_MGATE + h * 128), PRS, nullptr, 0);
                    }
                }
            }
        }
        GSYNC();
        {
            unsigned* qhead = (unsigned*)(p.ws + WS_CTL) + 4096 + ((2 * 2 + l) * 8 + (bx & 7)) * 64;
            LAS int* sq = (LAS int*)(lds + LDS_BYTES - 32);
            const int xbase = (bx & 7) * (G / 8);
            for (;;) {
                if (threadIdx.x == 0) *sq = (int)__hip_atomic_fetch_add(qhead, 1u, __ATOMIC_RELAXED, __HIP_MEMORY_SCOPE_AGENT);
                lds_barrier();
                const int q = *sq;
                if (q >= 128) break;
                gla_out_item(p, lds, l, xbase + (q & 31) + 256 * (q >> 5));
            }
        }
        GSYNC();
        for (int rep = 0; rep < NREP(32); ++rep) {
            __syncthreads();
            SchedMerge sch{(const char*)(p.ws + WS_Y), (const char*)(p.ws + WS_WT_BR) + (size_t)l * D_ * YW * 2, G, vcu};
            EpiMerge epi{(bf16_t*)(p.ws + WS_HREG), PROJ};
            gemm_phase(lds, YW, YW, sch, epi);
        }
        GSYNC();
        for (int rep = 0; rep < NREP(64); ++rep) {
            __syncthreads();
            SchedOut sch{(const char*)(p.ws + WS_HREG), (const char*)(p.ws + WS_WT_OUT) + (size_t)l * D_ * D_ * 2, G, vcu};
            EpiU epi{(bf16_t*)(p.ws + WS_BIG)};
            gemm_phase(lds, D_, D_, sch, epi);
        }
        GSYNC();
        __syncthreads();
        if (PH & 1024) phase_rows(p, lds, l + 1);
        if (l == 0) GSYNC();
    }
}

extern "C" void kernel_launch(void* const* d_in, const int* in_sizes, int n_in,
                              void* d_out, int out_size, void* d_ws, size_t ws_size,
                              hipStream_t stream) {
    static int grid_blocks = 0;
    if (!grid_blocks) {
        int dev = 0, cus = 0, per_cu = 0;
        hipGetDevice(&dev);
        hipDeviceGetAttribute(&cus, hipDeviceAttributeMultiprocessorCount, dev);
        hipFuncSetAttribute((const void*)fwd_megakernel, hipFuncAttributeMaxDynamicSharedMemorySize, LDS_BYTES);
        hipOccupancyMaxActiveBlocksPerMultiprocessor(&per_cu, (const void*)fwd_megakernel, NTHREADS, LDS_BYTES);
        (void)hipGetLastError();
        grid_blocks = cus;
        if (ws_size < WS_END || n_in != 18) { fprintf(stderr, "kernel_launch: workspace %zu < %zu or n_in %d != 18\n", ws_size, (size_t)WS_END, n_in); grid_blocks = -1; }
    }
    if (grid_blocks < 0) return;
    if (hipMemsetAsync((char*)d_ws + WS_CTL, 0, CTL_BYTES, stream) != hipSuccess) { fprintf(stderr, "kernel_launch: memset of the barrier words failed\n"); return; }
    Params p{};
    for (int i = 0; i < 18; ++i) p.in[i] = (const float*)d_in[i];
    p.out = (float*)d_out;
    p.ws = (unsigned char*)d_ws;
    void* args[] = {&p};
    hipError_t e = hipLaunchCooperativeKernel((const void*)fwd_megakernel, dim3(grid_blocks), dim3(NTHREADS), args, LDS_BYTES, stream);
    if (e != hipSuccess) fprintf(stderr, "cooperative launch failed: %s (grid %d)\n", hipGetErrorString(e), grid_blocks);
}
```

```cpp
#include <hip/hip_runtime.h>
#include <hip/hip_cooperative_groups.h>
#include <cstdio>
#include <cstdint>
namespace cg = cooperative_groups;

#define LAS __attribute__((address_space(3)))
typedef unsigned short bf16_t;
typedef short bf16x8 __attribute__((ext_vector_type(8)));
typedef float f32x4 __attribute__((ext_vector_type(4)));
typedef unsigned u32x4 __attribute__((ext_vector_type(4)));
typedef unsigned u32x2 __attribute__((ext_vector_type(2)));
typedef float f32x2 __attribute__((ext_vector_type(2)));

constexpr int S_ = 16384, D_ = 2048, NP = 19456, DIN = 19472;
constexpr int C_AVAL = 0, C_AGATE = 1024, C_SQ = 2048, C_SK = 3584, C_SV = 5120, C_SGATE = 6656, C_CQ = 7168, C_CK = 7680,
              C_CV = 8192, C_CGATE = 9216, C_MQ = 10240, C_MGATE = 10752, C_GL = 11264;
constexpr int YW = 3072, Y_POOL = 0, Y_SWA = 1024, Y_GLA = 1536, Y_MEM = 2560;
constexpr float EPS_ = 1e-6f, NEG_ = -1e30f;

__host__ __device__ __forceinline__ constexpr size_t pj(size_t t, int c) { return (size_t)(c >> 8) * ((size_t)16384 * 256) + t * 256 + (size_t)(c & 255); }
constexpr int PRS = 256;

constexpr size_t MiB = 1ull << 20;
constexpr size_t WS_WT_IN = 0;
constexpr size_t WS_WT_BR = 76 * MiB;
constexpr size_t WS_WT_OUT = 100 * MiB;
constexpr size_t WS_WT_MEMKV = 116 * MiB;
constexpr size_t WS_WT_POOL = 124 * MiB;
constexpr size_t WS_WT_LR = 125 * MiB;
constexpr size_t WS_MEMN = 126 * MiB;
constexpr size_t WS_MEMKV = 128 * MiB;
constexpr size_t WS_CTL = 129 * MiB;
constexpr size_t CTL_BYTES = 32768;
constexpr size_t WS_LSE = 130 * MiB;
constexpr size_t WS_DEC = 131 * MiB;
constexpr size_t WS_HREG = 134 * MiB;
constexpr size_t WS_Y = 198 * MiB;
constexpr size_t WS_SWAO = 294 * MiB;
constexpr size_t WS_SP = 342 * MiB;
constexpr size_t WS_BIG = 406 * MiB;
constexpr size_t WS_PROJ = 534 * MiB;
constexpr size_t WS_BC = 1142 * MiB;
constexpr size_t WS_END = 1174 * MiB;

#ifndef PH
#define PH 0xffff
#endif
#ifndef REP
#define REP 0
#endif
#define NREP(m) ((REP & (m)) ? 2 : 1)
#define GSYNC() do { xcd_barrier(xbar); if (REP & 0x2000) xcd_barrier(xbar); } while (0)
constexpr int LDS_BYTES = 144 * 1024;
constexpr int NTHREADS = 512;

struct Params {
    const float* in[18];
    float* out;
    unsigned char* ws;
};

#define LDS_WAIT() asm volatile("s_waitcnt lgkmcnt(0)" ::: "memory")
__device__ __forceinline__ unsigned f2bf(float f) { unsigned u = __float_as_uint(f); return (u + 0x7fffu + ((u >> 16) & 1u)) >> 16; }
typedef __bf16 bf16x2_t __attribute__((ext_vector_type(2)));
__device__ __forceinline__ unsigned pk2(float lo, float hi) { const bf16x2_t v = {(__bf16)lo, (__bf16)hi}; return __builtin_bit_cast(unsigned, v); }
__device__ __forceinline__ float bf2f(bf16_t b) { return __uint_as_float(((unsigned)b) << 16); }
__device__ __forceinline__ float bflo(unsigned w) { return __uint_as_float(w << 16); }
__device__ __forceinline__ float bfhi(unsigned w) { return __uint_as_float(w & 0xffff0000u); }
__device__ __forceinline__ float sigmoidf_(float x) { return __builtin_amdgcn_rcpf(1.0f + __expf(-x)); }
__device__ __forceinline__ float siluf_(float x) { return x * sigmoidf_(x); }
__device__ __forceinline__ float wave_sum(float v) {
#pragma unroll
    for (int o = 1; o < 64; o <<= 1) v += __shfl_xor(v, o);
    return v;
}
__device__ __forceinline__ int opaque_tid() { int t = threadIdx.x; asm volatile("" : "+v"(t)); return t; }
__device__ __forceinline__ void lds_barrier() { asm volatile("s_waitcnt lgkmcnt(0)\n\ts_barrier" ::: "memory"); }
__device__ __forceinline__ f32x4 mfma16(bf16x8 a, bf16x8 b, f32x4 c) { return __builtin_amdgcn_mfma_f32_16x16x32_bf16(a, b, c, 0, 0, 0); }

constexpr int HTB = 128 * 64 * 2;
__device__ __forceinline__ int lds_byte(int r, int c) { const int st = (r >> 4) * 2 + (c >> 5), rr = r & 15, cc = c & 31, ob = rr * 64 + cc * 2; return st * 1024 + (ob ^ (((ob >> 9) & 1) << 5)); }
__device__ __forceinline__ void stage_rc(int b, int& R, int& C) { const int st = b / 1024, sb = b % 1024, swz = sb ^ (((sb >> 9) & 1) << 5); R = (st >> 1) * 16 + swz / 64; C = (st & 1) * 32 + (swz % 64) / 2; }
__device__ __forceinline__ int perm32(int rho) { const int n = rho >> 4, i = rho & 15; return 8 * (i >> 2) + 4 * n + (i & 3); }

struct GUnit { const char* A; const char* B; int nt, pm, pn, tag; };

template <class Sched, class Epi>
__device__ __forceinline__ void gemm_phase(LAS unsigned char* lds, const int lda, const int ldb, const Sched& S, const Epi& E) {
    const int tid = opaque_tid(), wid = __builtin_amdgcn_readfirstlane(tid >> 6), lane = tid & 63, wr = wid >> 2, wc = wid & 3, fr = lane & 15, fq = lane >> 4;
    unsigned voffA[2], voffB[2];
#pragma unroll
    for (int i = 0; i < 2; ++i) { int R, C; stage_rc(tid * 16 + i * 8192, R, C); const int Rb = (R & ~31) + perm32(R & 31);
        voffA[i] = (unsigned)(R * lda + C) * 2u; voffB[i] = (unsigned)(Rb * ldb + C) * 2u; }
    const size_t kstep = 128;
    const size_t hstepA = (size_t)128 * lda * 2, hstepB = (size_t)128 * ldb * 2;
    const unsigned ldsw = (unsigned)wid * 1024u;
    const int aoff = lds_byte(wr * 64 + fr, fq * 8), boff = lds_byte(wc * 32 + fr, fq * 8);
#define G_SA(b, h) (((b) * 2 + (h)) * HTB)
#define G_SB(b, h) ((4 + (b) * 2 + (h)) * HTB)
#define G_STAGE(bufoff, gbase, voff) do { _Pragma("unroll") for (int _i = 0; _i < 2; ++_i) \
        __builtin_amdgcn_global_load_lds((const unsigned*)((const char*)(gbase) + (voff)[_i]), (LAS unsigned*)(lds + (bufoff) + ldsw + _i * 8192), 16, 0, 0); } while (0)
#define G_LDA(dst, b, h) do { _Pragma("unroll") for (int m = 0; m < 4; ++m) _Pragma("unroll") for (int k = 0; k < 2; ++k) dst[m][k] = *(const LAS bf16x8*)(lds + G_SA(b, h) + aoff + m * 2048 + k * 1024); } while (0)
#define G_LDB(dst, b, h) do { _Pragma("unroll") for (int n = 0; n < 2; ++n) _Pragma("unroll") for (int k = 0; k < 2; ++k) dst[n][k] = *(const LAS bf16x8*)(lds + G_SB(b, h) + boff + n * 2048 + k * 1024); } while (0)
#define G_MMA(ai, bj, At, Bt) do { __builtin_amdgcn_s_setprio(1); _Pragma("unroll") for (int m = 0; m < 4; ++m) _Pragma("unroll") for (int n = 0; n < 2; ++n) _Pragma("unroll") for (int k = 0; k < 2; ++k) \
        acc[ai][bj][m][n] = __builtin_amdgcn_mfma_f32_16x16x32_bf16(Bt[n][k], At[m][k], acc[ai][bj][m][n], 0, 0, 0); __builtin_amdgcn_s_setprio(0); } while (0)
#define G_WAIT_V(n) asm volatile("s_waitcnt vmcnt(" #n ")" ::: "memory")
#define G_WAIT_L(n) asm volatile("s_waitcnt lgkmcnt(" #n ")" ::: "memory")
#define G_BAR __builtin_amdgcn_s_barrier()
#define G_SCHED __builtin_amdgcn_sched_barrier(0)
    GUnit cur, nxt; int ui = 0;
    if (!S.next(0, cur)) return;
    f32x4 acc[2][2][4][2];
#pragma unroll
    for (int a = 0; a < 2; ++a)
#pragma unroll
        for (int b = 0; b < 2; ++b)
#pragma unroll
            for (int m = 0; m < 4; ++m)
#pragma unroll
                for (int n = 0; n < 2; ++n) acc[a][b][m][n] = (f32x4){0.f, 0.f, 0.f, 0.f};
    bf16x8 At[4][2], B0[2][2], B1[2][2];
    const char* cA = cur.A; const char* cB = cur.B;
    G_STAGE(G_SB(0, 0), cB, voffB); G_STAGE(G_SB(0, 1), cB + hstepB, voffB); G_STAGE(G_SA(0, 0), cA, voffA); G_STAGE(G_SA(0, 1), cA + hstepA, voffA);
    if (wr == 1) G_BAR;
    G_WAIT_V(2); G_BAR;
    G_STAGE(G_SB(1, 0), cB + kstep, voffB); G_STAGE(G_SA(1, 0), cA + kstep, voffA); G_STAGE(G_SB(1, 1), cB + hstepB + kstep, voffB);
    G_WAIT_V(6); G_BAR;
    for (;;) {
        const bool has_next = S.next(ui + 1, nxt);
        const char* nA = has_next ? nxt.A : cA; const char* nB = has_next ? nxt.B : cB;
        int nt = cur.nt; asm volatile("" : "+s"(nt));
        for (int t = 0; t < nt; t += 2) {
            const bool last = (t == nt - 2);
            const char* a1 = cA + (size_t)(t + 1) * kstep;
            const char* a2 = last ? nA : cA + (size_t)(t + 2) * kstep; const char* b2 = last ? nB : cB + (size_t)(t + 2) * kstep;
            const char* a3 = a2 + kstep; const char* b3 = b2 + kstep;
            G_LDB(B0, 0, 0); G_LDB(B1, 0, 1); G_SCHED; G_LDA(At, 0, 0); G_STAGE(G_SA(1, 1), a1 + hstepA, voffA);
            G_WAIT_V(8); G_WAIT_L(0); G_BAR; G_MMA(0, 0, At, B0); G_MMA(0, 1, At, B1); G_BAR; G_SCHED;
            G_LDA(At, 0, 1); G_STAGE(G_SB(0, 0), b2, voffB); G_STAGE(G_SB(0, 1), b2 + hstepB, voffB); G_STAGE(G_SA(0, 0), a2, voffA);
            G_WAIT_V(8); G_WAIT_L(0); G_BAR; G_MMA(1, 0, At, B0); G_MMA(1, 1, At, B1); G_BAR; G_SCHED;
            G_LDB(B0, 1, 0); G_LDB(B1, 1, 1); G_SCHED; G_LDA(At, 1, 0); G_STAGE(G_SA(0, 1), a2 + hstepA, voffA);
            G_WAIT_V(8); G_WAIT_L(0); G_BAR; G_MMA(0, 0, At, B0); G_MMA(0, 1, At, B1); G_BAR; G_SCHED;
            G_LDA(At, 1, 1); G_STAGE(G_SB(1, 0), b3, voffB); G_STAGE(G_SB(1, 1), b3 + hstepB, voffB); G_STAGE(G_SA(1, 0), a3, voffA);
            G_WAIT_V(8); G_WAIT_L(0); G_BAR; G_MMA(1, 0, At, B0); G_MMA(1, 1, At, B1); G_BAR; G_SCHED;
        }
        if (wr == 0) G_BAR;
        const bool keep = E(acc, cur, wr, wc, fr, fq);
        if (!has_next) break;
        if (!keep)
#pragma unroll
        for (int a = 0; a < 2; ++a)
#pragma unroll
            for (int b = 0; b < 2; ++b)
#pragma unroll
                for (int m = 0; m < 4; ++m)
#pragma unroll
                    for (int n = 0; n < 2; ++n) acc[a][b][m][n] = (f32x4){0.f, 0.f, 0.f, 0.f};
        cur = nxt; cA = nA; cB = nB; ++ui;
        if (wr == 1) G_BAR;
    }
    G_WAIT_V(0);
    G_BAR;
#undef G_SA
#undef G_SB
#undef G_STAGE
#undef G_LDA
#undef G_LDB
#undef G_MMA
#undef G_WAIT_V
#undef G_WAIT_L
#undef G_BAR
#undef G_SCHED
}

struct SchedProj {
    const char* A; const char* B; int G, c;
    __device__ __forceinline__ bool next(int i, GUnit& u) const {
        constexpr int nM = 64, nN = 76, nwg = nM * nN, NXCD = 8, WGM = 8;
        const int L = i * G + c; if (L >= nwg) return false;
        int wgid = L; { const int q = nwg / NXCD, r = nwg % NXCD, xcd = wgid % NXCD, off = wgid / NXCD; wgid = (xcd < r ? xcd * (q + 1) : r * (q + 1) + (xcd - r) * q) + off; }
        const int nig = WGM * nN, gid = wgid / nig, fm = gid * WGM, gsz = (nM - fm) < WGM ? (nM - fm) : WGM;
        u.pm = fm + ((wgid % nig) % gsz); u.pn = (wgid % nig) / gsz;
        u.A = A + (size_t)u.pm * 256 * D_ * 2; u.B = B + (size_t)u.pn * 256 * D_ * 2; u.nt = 32;
        const int pn = u.pn;
        u.tag = (pn >= 44) ? 2 : (((pn >= 4 && pn < 8) || pn == 26 || pn == 27 || (pn >= 36 && pn < 40) || pn == 42 || pn == 43) ? 1 : 0);
        return true;
    }
};
struct SchedMemKV {
    const char* A; const char* B; int b;
    __device__ __forceinline__ bool next(int i, GUnit& u) const {
        if (i > 0 || b >= 8) return false;
        const int ly = b >> 2; u.pm = ly; u.pn = b & 3; u.tag = 0; u.nt = 32;
        u.A = A + (size_t)ly * 256 * D_ * 2; u.B = B + ((size_t)ly * 1024 + (size_t)u.pn * 256) * D_ * 2;
        return true;
    }
};
struct SchedPool {
    const char* A; const char* B; int G, vcu;
    __device__ __forceinline__ bool next(int i, GUnit& u) const {
        const int T = vcu + G * i; if (T >= 256) return false;
        u.pm = T >> 2; u.pn = T & 3; u.tag = 0; u.nt = 4;
        u.A = A + ((size_t)u.pm * 256 * 1024 + (size_t)u.pn * 256) * 2; u.B = B + (size_t)u.pn * 65536 * 2;
        return true;
    }
};
struct SchedMerge {
    const char* A; const char* B; int G, vcu;
    __device__ __forceinline__ bool next(int i, GUnit& u) const {
        const int T = vcu + G * (i >> 2); if (T >= 512) return false;
        const int br = i & 3;
        const int koff = (br == 0) ? 0 : (br == 1 ? 1024 : (br == 2 ? 1536 : 2560));
        u.pm = T >> 3; u.pn = T & 7; u.tag = br; u.nt = (br & 1) ? 8 : 16;
        u.A = A + ((size_t)u.pm * 256 * YW + koff) * 2; u.B = B + ((size_t)u.pn * 256 * YW + koff) * 2;
        return true;
    }
};
struct SchedOut {
    const char* A; const char* B; int G, vcu;
    __device__ __forceinline__ bool next(int i, GUnit& u) const {
        const int T = vcu + G * i; if (T >= 512) return false;
        u.pm = T >> 3; u.pn = T & 7; u.tag = 0; u.nt = 32;
        u.A = A + (size_t)u.pm * 256 * D_ * 2; u.B = B + (size_t)u.pn * 256 * D_ * 2;
        return true;
    }
};

struct EpiBf16 {
    bf16_t* O; int ldc; const float* bias; int rowsel;
    __device__ __forceinline__ bool operator()(f32x4 (&acc)[2][2][4][2], const GUnit& u, int wr, int wc, int fr, int fq) const {
        const int mode = u.tag;
        const int row0 = u.pm * 256 + wr * 64 + fr;
        if (mode == 2) {
            const int chn0 = (u.pn - 44) * 64 + wc * 16 + fq * 4;
            const f32x4 bb0 = *(const f32x4*)(bias + chn0), bb1 = *(const f32x4*)(bias + 2048 + chn0), bb2 = *(const f32x4*)(bias + 4096 + chn0), bb3 = *(const f32x4*)(bias + 6144 + chn0);
#pragma unroll
            for (int ai = 0; ai < 2; ++ai)
#pragma unroll
                for (int m = 0; m < 4; ++m) {
                    bf16_t* rowp = O + pj((size_t)(row0 + ai * 128 + m * 16), C_GL + chn0);
                    const f32x4 z0 = acc[ai][0][m][0] + bb0, z1 = acc[ai][0][m][1] + bb1, z2 = acc[ai][1][m][0] + bb2, z3 = acc[ai][1][m][1] + bb3;
                    f32x4 r0, r1, r2, r3;
#pragma unroll
                    for (int j = 0; j < 4; ++j) {
                        const float E0 = fminf(1.0f + __expf(-z0[j]), 1e30f), E1 = fminf(1.0f + __expf(-z1[j]), 1e30f), E2 = fminf(1.0f + __expf(-z2[j]), 1e30f), E3 = fminf(1.0f + __expf(-z3[j]), 1e30f);
                        const float i0 = __builtin_amdgcn_rcpf(E0), i1 = __builtin_amdgcn_rcpf(E1), i2 = __builtin_amdgcn_rcpf(E2), i3 = __builtin_amdgcn_rcpf(E3);
                        r0[j] = E1 * i0; r1[j] = E2 * i1; r2[j] = E3 * i2; r3[j] = i3;
                    }
                    u32x2 w;
                    w.x = pk2(r0[0], r0[1]); w.y = pk2(r0[2], r0[3]); *(u32x2*)(rowp) = w;
                    w.x = pk2(r1[0], r1[1]); w.y = pk2(r1[2], r1[3]); *(u32x2*)(rowp + 8 * (size_t)16384 * 256) = w;
                    w.x = pk2(r2[0], r2[1]); w.y = pk2(r2[2], r2[3]); *(u32x2*)(rowp + 16 * (size_t)16384 * 256) = w;
                    w.x = pk2(r3[0], r3[1]); w.y = pk2(r3[2], r3[3]); *(u32x2*)(rowp + 24 * (size_t)16384 * 256) = w;
                }
            return false;
        }
        const int col0 = u.pn * 256 + wc * 32 + 8 * fq;
#pragma unroll
        for (int bj = 0; bj < 2; ++bj)
#pragma unroll
            for (int ai = 0; ai < 2; ++ai)
#pragma unroll
                for (int m = 0; m < 4; ++m) {
                    bf16_t* rowp = O + pj((size_t)(row0 + ai * 128 + m * 16), col0 + bj * 128);
                    f32x4 v0 = acc[ai][bj][m][0], v1 = acc[ai][bj][m][1];
                    if (mode != 0) {
#pragma unroll
                        for (int j = 0; j < 4; ++j) { v0[j] = siluf_(v0[j]); v1[j] = siluf_(v1[j]); }
                    }
                    u32x4 w; w.x = pk2(v0[0], v0[1]); w.y = pk2(v0[2], v0[3]); w.z = pk2(v1[0], v1[1]); w.w = pk2(v1[2], v1[3]);
                    *(u32x4*)rowp = w;
                }
        return false;
    }
};
struct EpiPool {
    bf16_t* Y; const bf16_t* proj; const float* scale;
    __device__ __forceinline__ bool operator()(f32x4 (&acc)[2][2][4][2], const GUnit& u, int wr, int wc, int fr, int fq) const {
        const int row0 = u.pm * 256 + wr * 64 + fr, col0 = u.pn * 256 + wc * 32 + 8 * fq;
        f32x4 sc[2][2];
#pragma unroll
        for (int bj = 0; bj < 2; ++bj) { sc[bj][0] = *(const f32x4*)(scale + col0 + bj * 128); sc[bj][1] = *(const f32x4*)(scale + col0 + bj * 128 + 4); }
#pragma unroll
        for (int ai = 0; ai < 2; ++ai) {
            u32x4 g[4][2];
#pragma unroll
            for (int m = 0; m < 4; ++m)
#pragma unroll
                for (int bj = 0; bj < 2; ++bj) g[m][bj] = *(const u32x4*)(proj + pj((size_t)(row0 + ai * 128 + m * 16), C_AGATE + col0 + bj * 128));
#pragma unroll
            for (int m = 0; m < 4; ++m) {
                const size_t row = (size_t)(row0 + ai * 128 + m * 16);
#pragma unroll
                for (int bj = 0; bj < 2; ++bj) {
                    const u32x4 gg = g[m][bj];
                    const f32x4 v0 = acc[ai][bj][m][0] * sc[bj][0], v1 = acc[ai][bj][m][1] * sc[bj][1];
                    u32x4 w; w.x = pk2(v0[0] * bflo(gg.x), v0[1] * bfhi(gg.x)); w.y = pk2(v0[2] * bflo(gg.y), v0[3] * bfhi(gg.y));
                    w.z = pk2(v1[0] * bflo(gg.z), v1[1] * bfhi(gg.z)); w.w = pk2(v1[2] * bflo(gg.w), v1[3] * bfhi(gg.w));
                    *(u32x4*)(Y + row * YW + col0 + bj * 128) = w;
                }
            }
            asm volatile("" ::: "memory");
        }
        return false;
    }
};
struct EpiMerge {
    bf16_t* M; const bf16_t* proj;
    __device__ __forceinline__ bool operator()(f32x4 (&acc)[2][2][4][2], const GUnit& u, int wr, int wc, int fr, int fq) const {
        const int br = u.tag;
        const int row0 = u.pm * 256 + wr * 64 + fr, col0 = u.pn * 256 + wc * 32 + 8 * fq;
#pragma unroll
        for (int ai = 0; ai < 2; ++ai) {
            u32x4 g[4][2];
#pragma unroll
            for (int m = 0; m < 4; ++m)
#pragma unroll
                for (int bj = 0; bj < 2; ++bj) g[m][bj] = *(const u32x4*)(proj + pj((size_t)(row0 + ai * 128 + m * 16), C_GL + br * 2048 + col0 + bj * 128));
#pragma unroll
            for (int m = 0; m < 4; ++m) {
                const size_t row = (size_t)(row0 + ai * 128 + m * 16);
#pragma unroll
                for (int bj = 0; bj < 2; ++bj) {
                    const int col = col0 + bj * 128;
                    const u32x4 gg = g[m][bj];
                    f32x4 v0 = acc[ai][bj][m][0], v1 = acc[ai][bj][m][1];
                    v0[0] *= bflo(gg.x); v0[1] *= bfhi(gg.x); v0[2] *= bflo(gg.y); v0[3] *= bfhi(gg.y);
                    v1[0] *= bflo(gg.z); v1[1] *= bfhi(gg.z); v1[2] *= bflo(gg.w); v1[3] *= bfhi(gg.w);
                    if (br < 3) { acc[ai][bj][m][0] = v0; acc[ai][bj][m][1] = v1; }
                    else { u32x4 w; w.x = pk2(v0[0], v0[1]); w.y = pk2(v0[2], v0[3]); w.z = pk2(v1[0], v1[1]); w.w = pk2(v1[2], v1[3]);
                        *(u32x4*)(M + row * D_ + col) = w; }
                }
            }
            asm volatile("" ::: "memory");
        }
        return br < 3;
    }
};
struct EpiU {
    bf16_t* C;
    __device__ __forceinline__ bool operator()(f32x4 (&acc)[2][2][4][2], const GUnit& u, int wr, int wc, int fr, int fq) const {
        const int row0 = u.pm * 256 + wr * 64 + fr, col0 = u.pn * 256 + wc * 32 + 8 * fq;
#pragma unroll
        for (int ai = 0; ai < 2; ++ai)
#pragma unroll
            for (int m = 0; m < 4; ++m) {
                bf16_t* rowp = C + (size_t)(row0 + ai * 128 + m * 16) * D_ + col0;
#pragma unroll
                for (int bj = 0; bj < 2; ++bj) { const f32x4 v0 = acc[ai][bj][m][0], v1 = acc[ai][bj][m][1];
                    u32x4 w; w.x = pk2(v0[0], v0[1]); w.y = pk2(v0[2], v0[3]); w.z = pk2(v1[0], v1[1]); w.w = pk2(v1[2], v1[3]); *(u32x4*)(rowp + bj * 128) = w; }
            }
        return false;
    }
};

__device__ __forceinline__ int gate_rowmap(int g) {
    const int b = g >> 11, chn = g & 2047, q = chn >> 6, ch = chn & 63;
    return q * 256 + (b >> 1) * 128 + (ch >> 4) * 32 + ((ch >> 2) & 3) * 8 + (b & 1) * 4 + (ch & 3);
}
template <bool GMAP>
__device__ __forceinline__ void transpose_item(const float* W, int src_ld, int nvalid, bf16_t* WT, int dst_ld, int dst_k0, LAS float* scr, int kb, int nb, int lane) {
    const int k0 = 64 * kb, n0 = 64 * nb;
    const int krow = lane >> 4, nq = lane & 15, fr = lane & 15, fq = lane >> 4;
    const bool ok = (n0 + 4 * nq) < nvalid;
    const float* src = W + (size_t)(k0 + krow) * src_ld + n0 + 4 * nq;
    f32x4 v[16];
#pragma unroll
    for (int i = 0; i < 16; ++i) v[i] = ok ? *(const f32x4*)(src + (size_t)(4 * i) * src_ld) : (f32x4){0.f, 0.f, 0.f, 0.f};
    LAS unsigned char* tile = (LAS unsigned char*)scr;
#pragma unroll
    for (int i = 0; i < 16; ++i) { u32x2 w; w.x = pk2(v[i].x, v[i].y); w.y = pk2(v[i].z, v[i].w); *(LAS u32x2*)(tile + (4 * i + krow) * 160 + nq * 8) = w; }
    LDS_WAIT();
    const unsigned tb = (unsigned)(uintptr_t)tile + (unsigned)((8 * fq + (fr >> 2)) * 160 + 8 * (fr & 3));
#pragma unroll
    for (int nt = 0; nt < 4; ++nt)
#pragma unroll
        for (int kh = 0; kh < 2; ++kh) {
            u32x2 a, b;
            asm volatile("ds_read_b64_tr_b16 %0, %2\n\tds_read_b64_tr_b16 %1, %2 offset:640\n\ts_waitcnt lgkmcnt(0)" : "=&v"(a), "=&v"(b) : "v"(tb + (unsigned)(kh * 32 * 160 + nt * 32)) : "memory");
            const int n = n0 + nt * 16 + fr;
            const int drow = GMAP ? gate_rowmap(n) : n;
            if (n < nvalid) *(u32x4*)(WT + (size_t)drow * dst_ld + dst_k0 + k0 + kh * 32 + 8 * fq) = (u32x4){a.x, a.y, b.x, b.y};
        }
}
template <bool GMAP = false>
__device__ __forceinline__ void cvt_job(const float* W, int src_ld, int K, int N, bf16_t* WT, int dst_ld, int dst_k0, LAS float* scr, int gw, int NGW, int lane) {
    const int nblk = (N + 63) / 64, items = (K / 64) * nblk;
    for (int it = gw; it < items; it += NGW) transpose_item<GMAP>(W, src_ld, N, WT, dst_ld, dst_k0, scr, it / nblk, it % nblk, lane);
}
__device__ __forceinline__ void cvt_win(const Params& p, int l, LAS float* scr, int gw, int NGW, int lane) {
    const float* w = p.in[5] + (size_t)l * D_ * DIN;
    bf16_t* wt = (bf16_t*)(p.ws + WS_WT_IN);
    cvt_job(w, DIN, D_, 10240, wt, D_, 0, scr, gw, NGW, lane);
    cvt_job(w + 10256, DIN, D_, 1024, wt + (size_t)10240 * D_, D_, 0, scr, (gw + NGW / 2) % NGW, NGW, lane);
    cvt_job<true>(w + 11280, DIN, D_, 8192, wt + (size_t)C_GL * D_, D_, 0, scr, (gw + NGW / 4) % NGW, NGW, lane);
}
__device__ __forceinline__ void cvt_win_item(const Params& p, int l, LAS float* scr, int id, int lane) {
    const float* w = p.in[5] + (size_t)l * D_ * DIN;
    bf16_t* wt = (bf16_t*)(p.ws + WS_WT_IN);
    const int kb = id / 304, nbg = id % 304;
    if (nbg < 160) transpose_item<false>(w, DIN, 10240, wt, D_, 0, scr, kb, nbg, lane);
    else if (nbg < 176) transpose_item<false>(w + 10256, DIN, 1024, wt + (size_t)10240 * D_, D_, 0, scr, kb, nbg - 160, lane);
    else transpose_item<true>(w + 11280, DIN, 8192, wt + (size_t)C_GL * D_, D_, 0, scr, kb, nbg - 176, lane);
}
__device__ __forceinline__ void norm_row_store(const f32x4 (&v)[8], const float* g, bf16_t* orow, int lane) {
    float ss = 0.f;
#pragma unroll
    for (int j = 0; j < 8; ++j) ss += (v[j].x * v[j].x + v[j].y * v[j].y) + (v[j].z * v[j].z + v[j].w * v[j].w);
    ss = wave_sum(ss);
    const float rs = rsqrtf(ss * (1.0f / D_) + EPS_);
    u32x2* o8 = (u32x2*)orow + lane;
#pragma unroll
    for (int j = 0; j < 8; ++j) { const f32x4 gg = *((const f32x4*)g + lane + 64 * j);
        u32x2 w; w.x = pk2(v[j].x * rs * gg.x, v[j].y * rs * gg.y); w.y = pk2(v[j].z * rs * gg.z, v[j].w * rs * gg.w); o8[64 * j] = w; }
}

__device__ __forceinline__ void phase_rows(const Params& p, LAS unsigned char* lds, int stage) {
    const int tid = opaque_tid(), lane = tid & 63, wave = tid >> 6;
    const int gw = blockIdx.x * 8 + wave, NGW = gridDim.x * 8;
    LAS float* scr = (LAS float*)(lds + wave * 10240);
    if (stage == 0) {
        cvt_win(p, 0, scr, gw, NGW, lane);
        int rot = 0;
#pragma unroll 1
        for (int l = 0; l < 2; ++l) {
            cvt_job(p.in[5] + (size_t)l * D_ * DIN + 10240, DIN, D_, 16, (bf16_t*)(p.ws + WS_WT_LR) + (size_t)l * 16 * D_, D_, 0, scr, (gw + rot) % NGW, NGW, lane); rot += 64;
#pragma unroll 1
            for (int g = 0; g < 4; ++g) { cvt_job(p.in[7] + (size_t)(l * 4 + g) * 65536, 256, 256, 256, (bf16_t*)(p.ws + WS_WT_POOL) + (size_t)(l * 4 + g) * 65536, 256, 0, scr, (gw + rot) % NGW, NGW, lane); rot += 32; }
            cvt_job(p.in[12] + (size_t)l * D_ * 1024, 1024, D_, 1024, (bf16_t*)(p.ws + WS_WT_MEMKV) + (size_t)l * 1024 * D_, D_, 0, scr, (gw + rot) % NGW, NGW, lane); rot += 1024;
            bf16_t* wbr = (bf16_t*)(p.ws + WS_WT_BR) + (size_t)l * D_ * YW;
            cvt_job(p.in[13] + (size_t)l * 1024 * D_, D_, 1024, D_, wbr, YW, 0, scr, (gw + rot) % NGW, NGW, lane); rot += 1024;
            cvt_job(p.in[14] + (size_t)l * 512 * D_, D_, 512, D_, wbr, YW, 1024, scr, (gw + rot) % NGW, NGW, lane); rot += 512;
            cvt_job(p.in[15] + (size_t)l * 1024 * D_, D_, 1024, D_, wbr, YW, 1536, scr, (gw + rot) % NGW, NGW, lane); rot += 1024;
            cvt_job(p.in[16] + (size_t)l * 512 * D_, D_, 512, D_, wbr, YW, 2560, scr, (gw + rot) % NGW, NGW, lane); rot += 512;
            cvt_job(p.in[17] + (size_t)l * D_ * D_, D_, D_, D_, (bf16_t*)(p.ws + WS_WT_OUT) + (size_t)l * D_ * D_, D_, 0, scr, (gw + rot) % NGW, NGW, lane);
        }
        for (int r = gw; r < 512; r += NGW) {
            const int l = r >> 8, m = r & 255;
            const f32x4* xr = (const f32x4*)(p.in[1] + (size_t)m * D_) + lane;
            f32x4 v[8];
#pragma unroll
            for (int j = 0; j < 8; ++j) v[j] = xr[64 * j];
            norm_row_store(v, p.in[4] + (size_t)l * D_, (bf16_t*)(p.ws + WS_MEMN) + (size_t)r * D_, lane);
        }
    }
    const bf16_t* U = (const bf16_t*)(p.ws + WS_BIG);
    bf16_t* H = (bf16_t*)(p.ws + WS_HREG);
    const float* xsrc = p.in[0];
    bf16_t* X1B = (bf16_t*)(p.ws + WS_BIG + 64 * MiB);
    f32x4 gpost[8], gpre[8];
#pragma unroll
    for (int jj = 0; jj < 4; ++jj)
#pragma unroll
        for (int hlf = 0; hlf < 2; ++hlf) { const int q = 2 * (lane + 64 * jj) + hlf;
            gpost[2 * jj + hlf] = (stage >= 1) ? *((const f32x4*)(p.in[3] + (size_t)(stage - 1) * D_) + q) : (f32x4){0.f, 0.f, 0.f, 0.f};
            gpre[2 * jj + hlf] = (stage < 2) ? *((const f32x4*)(p.in[2] + (size_t)(stage == 0 ? 0 : 1) * D_) + q) : (f32x4){0.f, 0.f, 0.f, 0.f}; }
    u32x4 ua[4], ub[4]; f32x4 xa[8], xb[8];
#define UNPK(w_, lo_, hi_) do { lo_ = (f32x4){bflo(w_.x), bfhi(w_.x), bflo(w_.y), bfhi(w_.y)}; hi_ = (f32x4){bflo(w_.z), bfhi(w_.z), bflo(w_.w), bfhi(w_.w)}; } while (0)
#define ROW_LOAD(U_, X_, r_) do { const f32x4* xr_ = (const f32x4*)(xsrc + (size_t)(r_) * D_); const u32x4* ur_ = (const u32x4*)(U + (size_t)(r_) * D_); \
        const u32x4* xb_ = (const u32x4*)(X1B + (size_t)(r_) * D_); \
        _Pragma("unroll") for (int jj = 0; jj < 4; ++jj) { const int q_ = lane + 64 * jj; \
            if (stage == 2) { const u32x4 w_ = xb_[q_]; UNPK(w_, X_[2 * jj], X_[2 * jj + 1]); } else { X_[2 * jj] = xr_[2 * q_]; X_[2 * jj + 1] = xr_[2 * q_ + 1]; } \
            U_[jj] = (stage >= 1) ? ur_[q_] : (u32x4){0u, 0u, 0u, 0u}; } } while (0)
#define ROW_PROC(U_, X_, r_) do { f32x4 v[8]; \
        if (stage == 0) { _Pragma("unroll") for (int j = 0; j < 8; ++j) v[j] = X_[j]; } \
        else { f32x4 uu[8]; float ss = 0.f; \
            _Pragma("unroll") for (int jj = 0; jj < 4; ++jj) UNPK(U_[jj], uu[2 * jj], uu[2 * jj + 1]); \
            _Pragma("unroll") for (int j = 0; j < 8; ++j) ss += (uu[j].x * uu[j].x + uu[j].y * uu[j].y) + (uu[j].z * uu[j].z + uu[j].w * uu[j].w); \
            ss = wave_sum(ss); const float rs = rsqrtf(ss * (1.0f / D_) + EPS_); \
            f32x4* orow = (f32x4*)(p.out + (size_t)(r_) * D_); u32x4* xrow = (u32x4*)(X1B + (size_t)(r_) * D_); \
            _Pragma("unroll") for (int j = 0; j < 8; ++j) v[j] = X_[j] + uu[j] * rs * gpost[j]; \
            _Pragma("unroll") for (int jj = 0; jj < 4; ++jj) { const int q_ = lane + 64 * jj; \
                if (stage == 2) { orow[2 * q_] = v[2 * jj]; orow[2 * q_ + 1] = v[2 * jj + 1]; } \
                else { u32x4 w_; w_.x = pk2(v[2 * jj].x, v[2 * jj].y); w_.y = pk2(v[2 * jj].z, v[2 * jj].w); w_.z = pk2(v[2 * jj + 1].x, v[2 * jj + 1].y); w_.w = pk2(v[2 * jj + 1].z, v[2 * jj + 1].w); xrow[q_] = w_; } } } \
        if (stage < 2) { float s2 = 0.f; \
            _Pragma("unroll") for (int j = 0; j < 8; ++j) s2 += (v[j].x * v[j].x + v[j].y * v[j].y) + (v[j].z * v[j].z + v[j].w * v[j].w); \
            s2 = wave_sum(s2); const float r2 = rsqrtf(s2 * (1.0f / D_) + EPS_); \
            u32x4* o16 = (u32x4*)(H + (size_t)(r_) * D_); \
            _Pragma("unroll") for (int jj = 0; jj < 4; ++jj) { const f32x4 h0 = v[2 * jj] * r2 * gpre[2 * jj], h1 = v[2 * jj + 1] * r2 * gpre[2 * jj + 1]; \
                u32x4 w; w.x = pk2(h0.x, h0.y); w.y = pk2(h0.z, h0.w); w.z = pk2(h1.x, h1.y); w.w = pk2(h1.z, h1.w); o16[lane + 64 * jj] = w; } } } while (0)
    int row = gw;
    if (row < S_) ROW_LOAD(ua, xa, row);
    while (row < S_) {
        const int n1 = row + NGW;
        if (n1 < S_) ROW_LOAD(ub, xb, n1);
        ROW_PROC(ua, xa, row);
        if (n1 >= S_) break;
        const int n2 = n1 + NGW;
        if (n2 < S_) ROW_LOAD(ua, xa, n2);
        ROW_PROC(ub, xb, n1);
        row = n2;
    }
#undef ROW_LOAD
#undef ROW_PROC
#undef UNPK
}

__device__ __forceinline__ float logsigmoidf_(float z) { return fminf(z, 0.f) - __logf(1.0f + __expf(-fabsf(z))); }
__device__ __forceinline__ void lr_gemm(const Params& p, LAS unsigned char* lds, int l) {
    const int tid = opaque_tid(), lane = tid & 63, wid = tid >> 6, fr = lane & 15, fq = lane >> 4;
    const bf16_t* H = (const bf16_t*)(p.ws + WS_HREG);
    const bf16_t* WL = (const bf16_t*)(p.ws + WS_WT_LR) + (size_t)l * 16 * D_;
    float* BC = (float*)(p.ws + WS_BC);
    LAS float* sRed = (LAS float*)lds;
    LAS float* sLR = (LAS float*)(lds + 8192);
    for (int tb = blockIdx.x; tb < 256; tb += gridDim.x) {
        lds_barrier();
        const int mt = wid & 3, kh = wid >> 2;
        const bf16_t* hrow = H + (size_t)(tb * 64 + mt * 16 + fr) * D_ + kh * 1024 + fq * 8;
        const bf16_t* wrow = WL + (size_t)fr * D_ + kh * 1024 + fq * 8;
        f32x4 acc = (f32x4){0.f, 0.f, 0.f, 0.f};
#pragma unroll 8
        for (int ks = 0; ks < 32; ++ks) { const bf16x8 a = *(const bf16x8*)(hrow + ks * 32); const bf16x8 b = *(const bf16x8*)(wrow + ks * 32); acc = mfma16(a, b, acc); }
#pragma unroll
        for (int j = 0; j < 4; ++j) sRed[(kh * 64 + mt * 16 + fq * 4 + j) * 16 + fr] = acc[j];
        float wa[16];
#pragma unroll
        for (int r = 0; r < 16; ++r) wa[r] = p.in[9][(size_t)(l * 16 + r) * 512 + tid];
        const float b = p.in[10][l * 512 + tid];
        lds_barrier();
        for (int i = tid; i < 1024; i += NTHREADS) sLR[i] = sRed[i] + sRed[1024 + i];
        lds_barrier();
        float run = 0.f;
        float* bcp = BC + (size_t)tb * 64 * 512 + tid;
#pragma unroll 4
        for (int j = 0; j < 64; ++j) { float z = b;
#pragma unroll
            for (int r4 = 0; r4 < 4; ++r4) { const f32x4 v = *(const LAS f32x4*)(sLR + j * 16 + r4 * 4); z += v.x * wa[r4 * 4] + v.y * wa[r4 * 4 + 1] + v.z * wa[r4 * 4 + 2] + v.w * wa[r4 * 4 + 3]; }
            run += logsigmoidf_(z) * (1.0f / 16.0f); bcp[(size_t)j * 512] = run; }
    }
}

__device__ __forceinline__ bf16x8 cat_frag(u32x2 lo, u32x2 hi) { const u32x4 w = (u32x4){lo.x, lo.y, hi.x, hi.y}; return __builtin_bit_cast(bf16x8, w); }
template <int HALF>
__device__ __forceinline__ bf16x8 tr2(unsigned vb) {
    u32x2 a, b;
    asm volatile("ds_read_b64_tr_b16 %0, %2\n\tds_read_b64_tr_b16 %1, %2 offset:%3\n\ts_waitcnt lgkmcnt(0)" : "=&v"(a), "=&v"(b) : "v"(vb), "i"(HALF) : "memory");
    return cat_frag(a, b);
}
template <int HALF>
__device__ __forceinline__ void tr16(unsigned vb, u32x2 (&r)[16]) {
    asm volatile(
        "ds_read_b64_tr_b16 %0, %16 offset:%17\n\tds_read_b64_tr_b16 %1, %16 offset:%18\n\t"
        "ds_read_b64_tr_b16 %2, %16 offset:%19\n\tds_read_b64_tr_b16 %3, %16 offset:%20\n\t"
        "ds_read_b64_tr_b16 %4, %16 offset:%21\n\tds_read_b64_tr_b16 %5, %16 offset:%22\n\t"
        "ds_read_b64_tr_b16 %6, %16 offset:%23\n\tds_read_b64_tr_b16 %7, %16 offset:%24\n\t"
        "ds_read_b64_tr_b16 %8, %16 offset:%25\n\tds_read_b64_tr_b16 %9, %16 offset:%26\n\t"
        "ds_read_b64_tr_b16 %10, %16 offset:%27\n\tds_read_b64_tr_b16 %11, %16 offset:%28\n\t"
        "ds_read_b64_tr_b16 %12, %16 offset:%29\n\tds_read_b64_tr_b16 %13, %16 offset:%30\n\t"
        "ds_read_b64_tr_b16 %14, %16 offset:%31\n\tds_read_b64_tr_b16 %15, %16 offset:%32\n\t"
        "s_waitcnt lgkmcnt(0)"
        : "=&v"(r[0]), "=&v"(r[1]), "=&v"(r[2]), "=&v"(r[3]), "=&v"(r[4]), "=&v"(r[5]), "=&v"(r[6]), "=&v"(r[7]),
          "=&v"(r[8]), "=&v"(r[9]), "=&v"(r[10]), "=&v"(r[11]), "=&v"(r[12]), "=&v"(r[13]), "=&v"(r[14]), "=&v"(r[15])
        : "v"(vb), "i"(0), "i"(HALF), "i"(32), "i"(HALF + 32), "i"(64), "i"(HALF + 64), "i"(96), "i"(HALF + 96),
          "i"(128), "i"(HALF + 128), "i"(160), "i"(HALF + 160), "i"(192), "i"(HALF + 192), "i"(224), "i"(HALF + 224)
        : "memory");
}

template <int MODE, int NT>
__device__ __forceinline__ void attn_item(LAS unsigned char* lds, const bf16_t* qbase, size_t qrs, const bf16_t* kbase, const bf16_t* vbase, size_t krs, bool first,
                                          float slope_dil, bf16_t* obase, size_t ors, const bf16_t* gbase, size_t grs, float* lsebase, size_t lrs) {
    const int tid = opaque_tid(), lane = tid & 63, wid = tid >> 6, fr = lane & 15, fq = lane >> 4;
    LAS bf16_t* sK = (LAS bf16_t*)lds;
    LAS bf16_t* sV = (LAS bf16_t*)(lds + 69632);
    lds_barrier();
#pragma unroll
    for (int i = 0; i < 8; ++i) { const int id = tid + 512 * i, row = id >> 4, ch = id & 15;
        u32x4 kv = (u32x4){0u, 0u, 0u, 0u}, vv = (u32x4){0u, 0u, 0u, 0u};
        if (!(first && row < 128)) { kv = *(const u32x4*)(kbase + (ptrdiff_t)row * (ptrdiff_t)krs + ch * 8); vv = *(const u32x4*)(vbase + (ptrdiff_t)row * (ptrdiff_t)krs + ch * 8); }
        *(LAS u32x4*)(sK + row * 136 + ch * 8) = kv; *(LAS u32x4*)(sV + row * 144 + ch * 8) = vv; }
    bf16x8 qf[4];
    { const bf16_t* qrow = qbase + (size_t)(16 * wid + fr) * qrs + fq * 8;
#pragma unroll
      for (int kk = 0; kk < 4; ++kk) qf[kk] = *(const bf16x8*)(qrow + kk * 32); }
    lds_barrier();
    const int T_lo = (NT == 16) ? 0 : 2 * (wid >> 1);
    f32x4 s[NT];
#pragma unroll
    for (int ti = 0; ti < NT; ++ti) { s[ti] = (f32x4){0.f, 0.f, 0.f, 0.f};
#pragma unroll
        for (int kk = 0; kk < 4; ++kk) { const bf16x8 kf = *(const LAS bf16x8*)(sK + ((T_lo + ti) * 16 + fr) * 136 + kk * 32 + fq * 8); s[ti] = mfma16(kf, qf[kk], s[ti]); } }
    const float scale2 = 0.08838834764831845f * 1.4426950408889634f;
    const float slope2 = slope_dil * 1.4426950408889634f;
    const int qi = 16 * wid + fr;
    const int dbase = qi + 128 - T_lo * 16 - 4 * fq;
    const float cb = -slope2 * (float)dbase;
    const int kmin = first ? 128 - T_lo * 16 - 4 * fq : -1000;
    float mx = -3.0e38f;
#pragma unroll
    for (int ti = 0; ti < NT; ++ti)
#pragma unroll
        for (int j = 0; j < 4; ++j) {
            float v;
            if (MODE == 1) { const int off = 16 * ti + j;
                const bool valid = ((unsigned)(dbase - off) <= 128u) && (off >= kmin);
                v = valid ? fmaf(s[ti][j], scale2, fmaf(slope2, (float)off, cb)) : NEG_; }
            else v = s[ti][j] * scale2;
            s[ti][j] = v; mx = fmaxf(mx, v);
        }
    mx = fmaxf(mx, __shfl_xor(mx, 16)); mx = fmaxf(mx, __shfl_xor(mx, 32));
    float sm = 0.f;
#pragma unroll
    for (int ti = 0; ti < NT; ++ti)
#pragma unroll
        for (int j = 0; j < 4; ++j) { const float e = __builtin_amdgcn_exp2f(s[ti][j] - mx); s[ti][j] = e; sm += e; }
    sm += __shfl_xor(sm, 16); sm += __shfl_xor(sm, 32);
    const float inv = 1.0f / sm;
    bf16x8 pf[NT / 2];
#pragma unroll
    for (int ks = 0; ks < NT / 2; ++ks) { u32x4 w; w.x = pk2(s[2 * ks][0] * inv, s[2 * ks][1] * inv); w.y = pk2(s[2 * ks][2] * inv, s[2 * ks][3] * inv);
        w.z = pk2(s[2 * ks + 1][0] * inv, s[2 * ks + 1][1] * inv); w.w = pk2(s[2 * ks + 1][2] * inv, s[2 * ks + 1][3] * inv); pf[ks] = __builtin_bit_cast(bf16x8, w); }
    f32x4 o[8];
#pragma unroll
    for (int dt = 0; dt < 8; ++dt) o[dt] = (f32x4){0.f, 0.f, 0.f, 0.f};
    const unsigned vb0 = (unsigned)(uintptr_t)sV + (unsigned)(((T_lo * 16 + 4 * fq + (fr >> 2)) * 144 + 4 * (fr & 3)) * 2);
#pragma unroll
    for (int ks = 0; ks < NT / 2; ++ks) {
        u32x2 r[16];
        const unsigned vb = vb0 + (unsigned)(ks * 9216);
        tr16<4608>(vb, r);
#pragma unroll
        for (int dt = 0; dt < 8; ++dt) o[dt] = mfma16(cat_frag(r[2 * dt], r[2 * dt + 1]), pf[ks], o[dt]);
    }
    const size_t i = (size_t)qi;
#pragma unroll
    for (int dt = 0; dt < 8; ++dt) { const int d = dt * 16 + 4 * fq; f32x4 val = o[dt];
        if (MODE == 0) { const u32x2 g = *(const u32x2*)(gbase + i * grs + d); val[0] *= bflo(g.x); val[1] *= bfhi(g.x); val[2] *= bflo(g.y); val[3] *= bfhi(g.y); }
        u32x2 w; w.x = pk2(val[0], val[1]); w.y = pk2(val[2], val[3]); *(u32x2*)(obase + i * ors + d) = w; }
    if (MODE == 1) { if (fq == 0) lsebase[i * lrs] = (mx + __builtin_amdgcn_logf(sm)) * 0.6931471805599453f; }
}

__device__ __forceinline__ void gla_kv_item(const Params& p, LAS unsigned char* lds, int l, int item) {
    const int tid = opaque_tid(), lane = tid & 63, wid = tid >> 6, fr = lane & 15, fq = lane >> 4;
    const int c = item >> 2, h = item & 3;
    LAS bf16_t* sKs = (LAS bf16_t*)lds;
    LAS bf16_t* sV = (LAS bf16_t*)(lds + 18432);
    const bf16_t* prow = (const bf16_t*)(p.ws + WS_PROJ) + (size_t)(c * 64) * PRS;
    const float* bcc = (const float*)(p.ws + WS_BC) + (size_t)(c * 64) * 512 + h * 128;
    lds_barrier();
#pragma unroll
    for (int i = 0; i < 2; ++i) { const int id = tid + 512 * i, j = id >> 4, ch = id & 15;
        const u32x4 kv = *(const u32x4*)(prow + pj((size_t)j, C_CK + h * 128 + ch * 8));
        const f32x4 b0 = *(const f32x4*)(bcc + (size_t)j * 512 + ch * 8), b1 = *(const f32x4*)(bcc + (size_t)j * 512 + ch * 8 + 4);
        const f32x4 l0 = *(const f32x4*)(bcc + (size_t)63 * 512 + ch * 8), l1 = *(const f32x4*)(bcc + (size_t)63 * 512 + ch * 8 + 4);
        u32x4 o;
        o.x = pk2(bflo(kv.x) * __expf(l0.x - b0.x), bfhi(kv.x) * __expf(l0.y - b0.y)); o.y = pk2(bflo(kv.y) * __expf(l0.z - b0.z), bfhi(kv.y) * __expf(l0.w - b0.w));
        o.z = pk2(bflo(kv.z) * __expf(l1.x - b1.x), bfhi(kv.z) * __expf(l1.y - b1.y)); o.w = pk2(bflo(kv.w) * __expf(l1.z - b1.z), bfhi(kv.w) * __expf(l1.w - b1.w));
        *(LAS u32x4*)(sKs + j * 144 + ch * 8) = o; }
#pragma unroll
    for (int i = 0; i < 4; ++i) { const int id = tid + 512 * i, j = id >> 5, ch = id & 31;
        *(LAS u32x4*)(sV + j * 272 + ch * 8) = *(const u32x4*)(prow + pj((size_t)j, C_CV + h * 256 + ch * 8)); }
    if (tid < 128) ((float*)(p.ws + WS_DEC))[(size_t)item * 128 + tid] = __expf(bcc[(size_t)63 * 512 + tid]);
    lds_barrier();
    f32x4 acc[8][2];
#pragma unroll
    for (int m = 0; m < 8; ++m) { acc[m][0] = (f32x4){0.f, 0.f, 0.f, 0.f}; acc[m][1] = (f32x4){0.f, 0.f, 0.f, 0.f}; }
    const unsigned kb0 = (unsigned)(uintptr_t)sKs + (unsigned)(((4 * fq + (fr >> 2)) * 144 + 4 * (fr & 3)) * 2);
    const unsigned vb0 = (unsigned)(uintptr_t)sV + (unsigned)(((4 * fq + (fr >> 2)) * 272 + 4 * (fr & 3)) * 2) + (unsigned)(wid * 64);
#pragma unroll
    for (int ks = 0; ks < 2; ++ks) {
        u32x2 r[16];
        tr16<4608>(kb0 + (unsigned)(ks * 32 * 288), r);
        const bf16x8 v0 = tr2<8704>(vb0 + (unsigned)(ks * 32 * 544)), v1 = tr2<8704>(vb0 + (unsigned)(ks * 32 * 544) + 32u);
#pragma unroll
        for (int m = 0; m < 8; ++m) { const bf16x8 kf = cat_frag(r[2 * m], r[2 * m + 1]); acc[m][0] = mfma16(kf, v0, acc[m][0]); acc[m][1] = mfma16(kf, v1, acc[m][1]); }
    }
    bf16_t* KV = (bf16_t*)(p.ws + WS_BIG) + (size_t)item * 32768;
#pragma unroll
    for (int n = 0; n < 2; ++n)
#pragma unroll
        for (int m = 0; m < 8; ++m) { u32x2 w; w.x = pk2(acc[m][n][0], acc[m][n][1]); w.y = pk2(acc[m][n][2], acc[m][n][3]);
            *(u32x2*)(KV + (size_t)((2 * wid + n) * 16 + fr) * 128 + m * 16 + 4 * fq) = w; }
}
__device__ __forceinline__ void gla_out_item(const Params& p, LAS unsigned char* lds, int l, int item) {
    const int tid = opaque_tid(), lane = tid & 63, wid = tid >> 6, fr = lane & 15, fq = lane >> 4;
    const int c = item >> 2, h = item & 3;
    LAS bf16_t* sQ = (LAS bf16_t*)lds;
    LAS bf16_t* sK2 = (LAS bf16_t*)(lds + 17408);
    LAS bf16_t* sV = (LAS bf16_t*)(lds + 34816);
    LAS float* sSS = (LAS float*)(lds + 69632);
    const bf16_t* PROJ = (const bf16_t*)(p.ws + WS_PROJ);
    const bf16_t* prow = PROJ + (size_t)(c * 64) * PRS;
    const float* bcc = (const float*)(p.ws + WS_BC) + (size_t)(c * 64) * 512 + h * 128;
    lds_barrier();
#pragma unroll
    for (int i = 0; i < 2; ++i) { const int id = tid + 512 * i, row = id >> 4, ch = id & 15;
        const u32x4 q8 = *(const u32x4*)(prow + pj((size_t)row, C_CQ + h * 128 + ch * 8));
        const u32x4 k8 = *(const u32x4*)(prow + pj((size_t)row, C_CK + h * 128 + ch * 8));
        const f32x4 b0 = *(const f32x4*)(bcc + (size_t)row * 512 + ch * 8), b1 = *(const f32x4*)(bcc + (size_t)row * 512 + ch * 8 + 4);
        const float sc = 0.08838834764831845f;
        u32x4 qo, ko;
        qo.x = pk2(bflo(q8.x) * sc * __expf(b0.x), bfhi(q8.x) * sc * __expf(b0.y)); qo.y = pk2(bflo(q8.y) * sc * __expf(b0.z), bfhi(q8.y) * sc * __expf(b0.w));
        qo.z = pk2(bflo(q8.z) * sc * __expf(b1.x), bfhi(q8.z) * sc * __expf(b1.y)); qo.w = pk2(bflo(q8.w) * sc * __expf(b1.z), bfhi(q8.w) * sc * __expf(b1.w));
        ko.x = pk2(bflo(k8.x) * __expf(-b0.x), bfhi(k8.x) * __expf(-b0.y)); ko.y = pk2(bflo(k8.y) * __expf(-b0.z), bfhi(k8.y) * __expf(-b0.w));
        ko.z = pk2(bflo(k8.z) * __expf(-b1.x), bfhi(k8.z) * __expf(-b1.y)); ko.w = pk2(bflo(k8.w) * __expf(-b1.z), bfhi(k8.w) * __expf(-b1.w));
        *(LAS u32x4*)(sQ + row * 136 + ch * 8) = qo; *(LAS u32x4*)(sK2 + row * 136 + ch * 8) = ko; }
#pragma unroll
    for (int i = 0; i < 4; ++i) { const int id = tid + 512 * i, j = id >> 5, ch = id & 31;
        *(LAS u32x4*)(sV + j * 272 + ch * 8) = *(const u32x4*)(prow + pj((size_t)j, C_CV + h * 256 + ch * 8)); }
    lds_barrier();
    const int it = wid & 3, nh = wid >> 2;
    bf16x8 qf[4];
#pragma unroll
    for (int kk = 0; kk < 4; ++kk) qf[kk] = *(const LAS bf16x8*)(sQ + (it * 16 + fr) * 136 + kk * 32 + fq * 8);
    bf16x8 pa[2];
    {
        f32x4 at[4];
#pragma unroll
        for (int jt = 0; jt < 4; ++jt) { at[jt] = (f32x4){0.f, 0.f, 0.f, 0.f};
#pragma unroll
            for (int kk = 0; kk < 4; ++kk) { const bf16x8 kf = *(const LAS bf16x8*)(sK2 + (jt * 16 + fr) * 136 + kk * 32 + fq * 8); at[jt] = mfma16(kf, qf[kk], at[jt]); }
#pragma unroll
            for (int jj = 0; jj < 4; ++jj) { const int j = jt * 16 + 4 * fq + jj, i = it * 16 + fr; at[jt][jj] = (j <= i) ? at[jt][jj] : 0.f; } }
#pragma unroll
        for (int ks = 0; ks < 2; ++ks) { u32x4 w; w.x = pk2(at[2 * ks][0], at[2 * ks][1]); w.y = pk2(at[2 * ks][2], at[2 * ks][3]);
            w.z = pk2(at[2 * ks + 1][0], at[2 * ks + 1][1]); w.w = pk2(at[2 * ks + 1][2], at[2 * ks + 1][3]); pa[ks] = __builtin_bit_cast(bf16x8, w); }
    }
    f32x4 o[8];
#pragma unroll
    for (int n8 = 0; n8 < 8; ++n8) o[n8] = (f32x4){0.f, 0.f, 0.f, 0.f};
    const unsigned vb0 = (unsigned)(uintptr_t)sV + (unsigned)(((4 * fq + (fr >> 2)) * 272 + 4 * (fr & 3)) * 2) + (unsigned)(nh * 256);
#pragma unroll
    for (int ks = 0; ks < 2; ++ks) {
        u32x2 r[16];
        tr16<8704>(vb0 + (unsigned)(ks * 32 * 544), r);
#pragma unroll
        for (int n8 = 0; n8 < 8; ++n8) o[n8] = mfma16(cat_frag(r[2 * n8], r[2 * n8 + 1]), pa[ks], o[n8]);
    }
    {
        const bf16_t* sp = (const bf16_t*)(p.ws + WS_SP) + (size_t)item * 32768 + (size_t)((nh * 8) * 16 + fr) * 128 + fq * 8;
#pragma unroll
        for (int n8 = 0; n8 < 8; ++n8)
#pragma unroll
            for (int kk = 0; kk < 4; ++kk) { const bf16x8 sf = *(const bf16x8*)(sp + (size_t)n8 * 16 * 128 + kk * 32); o[n8] = mfma16(sf, qf[kk], o[n8]); }
    }
    float a = 0.f;
#pragma unroll
    for (int n8 = 0; n8 < 8; ++n8) a += (o[n8][0] * o[n8][0] + o[n8][1] * o[n8][1]) + (o[n8][2] * o[n8][2] + o[n8][3] * o[n8][3]);
    a += __shfl_xor(a, 16); a += __shfl_xor(a, 32);
    if (fq == 0) sSS[nh * 64 + it * 16 + fr] = a;
    lds_barrier();
    const int i = it * 16 + fr;
    const float rstd = rsqrtf((sSS[i] + sSS[64 + i]) * (1.0f / 256.0f) + EPS_);
    const size_t t = (size_t)c * 64 + i;
    bf16_t* yrow = (bf16_t*)(p.ws + WS_Y) + t * YW + Y_GLA + h * 256;
    const bf16_t* grow = PROJ + pj(t, C_CGATE + h * 256);
    const float* gg = p.in[11] + (size_t)l * 1024 + h * 256;
#pragma unroll
    for (int n8 = 0; n8 < 8; ++n8) { const int vd = (nh * 8 + n8) * 16 + 4 * fq;
        const f32x4 g4 = *(const f32x4*)(gg + vd); const u32x2 gt = *(const u32x2*)(grow + vd);
        u32x2 w; w.x = pk2(o[n8][0] * rstd * g4.x * bflo(gt.x), o[n8][1] * rstd * g4.y * bfhi(gt.x)); w.y = pk2(o[n8][2] * rstd * g4.z * bflo(gt.y), o[n8][3] * rstd * g4.w * bfhi(gt.y));
        *(u32x2*)(yrow + vd) = w; }
}

__device__ __forceinline__ void memkv_item(const Params& p, int item) {
    const int tid = opaque_tid(), lane = tid & 63, wid = tid >> 6, fr = lane & 15, fq = lane >> 4;
    const int l = item >> 6, nt = item & 63;
    const bf16_t* A = (const bf16_t*)(p.ws + WS_MEMN) + (size_t)l * 256 * D_ + (size_t)(wid * 32 + fr) * D_ + fq * 8;
    const bf16_t* B = (const bf16_t*)(p.ws + WS_WT_MEMKV) + (size_t)l * 1024 * D_ + (size_t)(nt * 16 + fr) * D_ + fq * 8;
    f32x4 a0 = (f32x4){0.f, 0.f, 0.f, 0.f}, a1 = (f32x4){0.f, 0.f, 0.f, 0.f};
#pragma unroll 8
    for (int ks = 0; ks < 64; ++ks) { const bf16x8 b = *(const bf16x8*)(B + ks * 32);
        a0 = mfma16(*(const bf16x8*)(A + ks * 32), b, a0); a1 = mfma16(*(const bf16x8*)(A + (size_t)16 * D_ + ks * 32), b, a1); }
    bf16_t* O = (bf16_t*)(p.ws + WS_MEMKV) + (size_t)l * 256 * 1024 + nt * 16 + fr;
#pragma unroll
    for (int j = 0; j < 4; ++j) { O[(size_t)(wid * 32 + fq * 4 + j) * 1024] = (bf16_t)f2bf(a0[j]); O[(size_t)(wid * 32 + 16 + fq * 4 + j) * 1024] = (bf16_t)f2bf(a1[j]); }
}

template <int W>
__device__ __forceinline__ void pool_item(const Params& p, LAS unsigned char* lds, int l, int n, int g) {
    const int tid = opaque_tid(), lane = tid & 63, wid = tid >> 6, fr = lane & 15, fq = lane >> 4;
    LAS bf16_t* sA = (LAS bf16_t*)lds;
    LAS bf16_t* sB = (LAS bf16_t*)(lds + 67584);
    const bf16_t* PROJ = (const bf16_t*)(p.ws + WS_PROJ);
    const bf16_t* WP = (const bf16_t*)(p.ws + WS_WT_POOL) + (size_t)(l * 4 + g) * 65536;
    lds_barrier();
#pragma unroll
    for (int i = 0; i < 8; ++i) { const int id = tid + 512 * i, row = id >> 5, ch = id & 31;
        *(LAS u32x4*)(sB + row * 264 + ch * 8) = *(const u32x4*)(WP + (size_t)row * 256 + ch * 8); }
    {
        const int ch = tid & 31, run = tid >> 5, t0 = n * 128 + run * 8;
        const bf16_t* up = PROJ + pj((size_t)t0, C_AVAL + g * 256 + ch * 8);
        float a[8] = {0.f, 0.f, 0.f, 0.f, 0.f, 0.f, 0.f, 0.f};
#pragma unroll
        for (int j = 1; j < W; ++j) if (t0 - j >= 0) { const u32x4 v = *(const u32x4*)(up - (ptrdiff_t)j * PRS);
            a[0] += bflo(v.x); a[1] += bfhi(v.x); a[2] += bflo(v.y); a[3] += bfhi(v.y); a[4] += bflo(v.z); a[5] += bfhi(v.z); a[6] += bflo(v.w); a[7] += bfhi(v.w); }
#pragma unroll
        for (int sidx = 0; sidx < 8; ++sidx) { const int t = t0 + sidx;
            const u32x4 v = *(const u32x4*)(up + (ptrdiff_t)sidx * PRS);
            const float x[8] = {bflo(v.x), bfhi(v.x), bflo(v.y), bfhi(v.y), bflo(v.z), bfhi(v.z), bflo(v.w), bfhi(v.w)};
#pragma unroll
            for (int e = 0; e < 8; ++e) a[e] += x[e];
            const float ic = 1.0f / (float)((t + 1 < W) ? t + 1 : W);
            u32x4 o; o.x = pk2(a[0] * ic - x[0], a[1] * ic - x[1]); o.y = pk2(a[2] * ic - x[2], a[3] * ic - x[3]);
            o.z = pk2(a[4] * ic - x[4], a[5] * ic - x[5]); o.w = pk2(a[6] * ic - x[6], a[7] * ic - x[7]);
            *(LAS u32x4*)(sA + (run * 8 + sidx) * 264 + ch * 8) = o;
            if (t - W + 1 >= 0) { const u32x4 q = *(const u32x4*)(up + (ptrdiff_t)(sidx - W + 1) * PRS);
                a[0] -= bflo(q.x); a[1] -= bfhi(q.x); a[2] -= bflo(q.y); a[3] -= bfhi(q.y); a[4] -= bflo(q.z); a[5] -= bfhi(q.z); a[6] -= bflo(q.w); a[7] -= bfhi(q.w); }
        }
    }
    lds_barrier();
    bf16x8 af[8];
#pragma unroll
    for (int ks = 0; ks < 8; ++ks) af[ks] = *(const LAS bf16x8*)(sA + (16 * wid + fr) * 264 + ks * 32 + fq * 8);
    const size_t t = (size_t)n * 128 + 16 * wid + fr;
    bf16_t* yrow = (bf16_t*)(p.ws + WS_Y) + t * YW + Y_POOL + g * 256;
    const bf16_t* grow = PROJ + pj(t, C_AGATE + g * 256);
    const float* sc = p.in[8] + (size_t)l * 1024 + g * 256;
#pragma unroll
    for (int half = 0; half < 2; ++half) {
        if (half == 1) {
            lds_barrier();
#pragma unroll
            for (int i = 0; i < 8; ++i) { const int id = tid + 512 * i, row = id >> 5, ch = id & 31;
                *(LAS u32x4*)(sB + row * 264 + ch * 8) = *(const u32x4*)(WP + (size_t)(128 + row) * 256 + ch * 8); }
            lds_barrier();
        }
#pragma unroll
        for (int nt = 0; nt < 8; ++nt) {
            f32x4 acc = (f32x4){0.f, 0.f, 0.f, 0.f};
#pragma unroll
            for (int ks = 0; ks < 8; ++ks) { const bf16x8 bf = *(const LAS bf16x8*)(sB + (nt * 16 + fr) * 264 + ks * 32 + fq * 8); acc = mfma16(bf, af[ks], acc); }
            const int d = half * 128 + nt * 16 + 4 * fq;
            const f32x4 s4 = *(const f32x4*)(sc + d); const u32x2 gt = *(const u32x2*)(grow + d);
            u32x2 w; w.x = pk2(acc[0] * s4.x * bflo(gt.x), acc[1] * s4.y * bfhi(gt.x)); w.y = pk2(acc[2] * s4.z * bflo(gt.y), acc[3] * s4.w * bfhi(gt.y));
            *(u32x2*)(yrow + d) = w;
        }
    }
}

#define XB_TMO      128
#define XB_XCNT(j)  (256  + 64 * (j))
#define XB_XSUB(j)  (1280 + 64 * (j))
#define XB_XGEN(j)  (2304 + 64 * (j))
#define XB_TOP      3328
#define XB_TOPGEN   3392
#define XCD_BAR_WORDS 3456
#define XB_SPIN_CAP (1u << 18)
__device__ __forceinline__ unsigned xb_ld(unsigned* p)              { return __hip_atomic_load(p, __ATOMIC_RELAXED, __HIP_MEMORY_SCOPE_AGENT); }
__device__ __forceinline__ unsigned xb_add(unsigned* p, unsigned v) { return __hip_atomic_fetch_add(p, v, __ATOMIC_RELAXED, __HIP_MEMORY_SCOPE_AGENT); }
__device__ __forceinline__ unsigned xb_xcc_id() { return (unsigned)__builtin_amdgcn_s_getreg((3 << 11) | 20) & 0xFu; }
#define XB_SPIN(cond, bar) do { unsigned _sp = 0; while (cond) { __builtin_amdgcn_s_sleep(1); \
    if ((++_sp & 255u) == 0u) { if (xb_ld(&(bar)[XB_TMO])) break; if (_sp > XB_SPIN_CAP) { atomicAdd(&(bar)[XB_TMO], 1u); break; } } } } while (0)
struct XcdBarrier { unsigned* bar; unsigned x; volatile LAS unsigned* st; };
__device__ __forceinline__ XcdBarrier xcd_barrier_post(unsigned* bar, volatile LAS unsigned* st) {
    XcdBarrier b; b.bar = bar; b.x = xb_xcc_id(); b.st = st;
    if (threadIdx.x == 0) (void)xb_add(&bar[XB_XCNT(b.x)], 1u);
    return b;
}
__device__ __forceinline__ void xcd_barrier_complete(unsigned* bar, unsigned x, unsigned& nloc, unsigned& nx) {
    const unsigned G = gridDim.x * gridDim.y * gridDim.z;
    unsigned sum, cnt, mine, sp = 0u;
    for (;;) {
        sum = 0u; cnt = 0u; mine = 0u;
#pragma unroll
        for (unsigned j = 0; j < 16; ++j) { const unsigned c = xb_ld(&bar[XB_XCNT(j)]); sum += c; cnt += (c > 0u) ? 1u : 0u; mine = (j == x) ? c : mine; }
        if (sum == G) break;
        __builtin_amdgcn_s_sleep(1);
        if ((++sp & 255u) == 0u) { if (xb_ld(&bar[XB_TMO])) break; if (sp > XB_SPIN_CAP) { atomicAdd(&bar[XB_TMO], 1u); break; } }
    }
    nloc = mine > 0u ? mine : 1u; nx = cnt > 0u ? cnt : 1u;
}
__device__ __forceinline__ void xcd_barrier(const XcdBarrier& b) {
    asm volatile("s_waitcnt vmcnt(0)" ::: "memory");
    __syncthreads();
    if (threadIdx.x == 0) {
        unsigned* bar = b.bar;
        __builtin_amdgcn_s_waitcnt(0);
        unsigned nloc = b.st[0], nx = b.st[1];
        if (nloc == 0u) { xcd_barrier_complete(bar, b.x, nloc, nx); b.st[0] = nloc; b.st[1] = nx; }
        const unsigned old = xb_add(&bar[XB_XSUB(b.x)], 1u);
        const unsigned gen = old / nloc;
        if (old + 1u == (gen + 1u) * nloc) {
            __builtin_amdgcn_fence(__ATOMIC_RELEASE, "agent");
            asm volatile("s_waitcnt vmcnt(0)" ::: "memory");
            const unsigned og = xb_add(&bar[XB_TOP], 1u);
            const unsigned tg = og / nx;
            if (og + 1u == (tg + 1u) * nx) xb_add(&bar[XB_TOPGEN], 1u);
            else XB_SPIN(xb_ld(&bar[XB_TOPGEN]) == tg, bar);
            __builtin_amdgcn_fence(__ATOMIC_ACQUIRE, "agent");
            xb_add(&bar[XB_XGEN(b.x)], 1u);
            asm volatile("s_waitcnt vmcnt(0)" ::: "memory");
        } else {
            XB_SPIN(xb_ld(&bar[XB_XGEN(b.x)]) == gen, bar);
            __builtin_amdgcn_fence(__ATOMIC_ACQUIRE, "agent");
            asm volatile("s_waitcnt vmcnt(0)" ::: "memory");
        }
    }
    __syncthreads();
}

__global__ void __launch_bounds__(512, 2) fwd_megakernel(Params p) {
    extern __shared__ __attribute__((aligned(16))) unsigned char lds_raw[];
    LAS unsigned char* lds = (LAS unsigned char*)lds_raw;
    cg::grid_group grid = cg::this_grid();
    const int G = gridDim.x, bx = blockIdx.x;
    const int vcu = (G % 8 == 0) ? (bx % 8) * (G / 8) + bx / 8 : bx;
    bf16_t* PROJ = (bf16_t*)(p.ws + WS_PROJ);
    bf16_t* Y = (bf16_t*)(p.ws + WS_Y);

    {
        if (threadIdx.x < 4) ((LAS unsigned*)(lds + LDS_BYTES - 16))[threadIdx.x] = 0u;
        __syncthreads();
    }
    const XcdBarrier xbar = xcd_barrier_post((unsigned*)(p.ws + WS_CTL), (volatile LAS unsigned*)(lds + LDS_BYTES - 16));
    for (int rep = 0; rep < NREP(1); ++rep) phase_rows(p, lds, 0);
    xcd_barrier(xbar);
    if (p.out == nullptr) grid.sync();

#pragma unroll 1
    for (int l = 0; l < 2; ++l) {
        for (int rep = 0; rep < NREP(2); ++rep) {
            __syncthreads();
            SchedProj sch{(const char*)(p.ws + WS_HREG), (const char*)(p.ws + WS_WT_IN), G, bx};
            EpiBf16 epi{PROJ, NP, p.in[6] + (size_t)l * 8192, 0};
            gemm_phase(lds, D_, D_, sch, epi);
            lr_gemm(p, lds, l);
        }
        GSYNC();
        for (int rep = 0; rep < NREP(4); ++rep) {
            if (l == 0) for (int it = G - 1 - bx; it < 128; it += G) memkv_item(p, it);
            {
                unsigned* qhead = (unsigned*)(p.ws + WS_CTL) + 4096 + ((0 * 2 + l) * 8 + (bx & 7)) * 64;
                LAS int* sq = (LAS int*)(lds + LDS_BYTES - 32);
                const int xbase = (bx & 7) * (G / 8);
                for (;;) {
                    if (threadIdx.x == 0) *sq = (int)__hip_atomic_fetch_add(qhead, 1u, __ATOMIC_RELAXED, __HIP_MEMORY_SCOPE_AGENT);
                    lds_barrier();
                    const int q = *sq;
                    if (q >= 320) break;
                    if (q < 192) {
                        const int it = xbase + (q & 31) + 256 * (q >> 5);
                        const int g = it >> 9, x = it & 511, hs = x & 3, y = x >> 2;
                        const int dil = (g == 0) ? 1 : (g == 1 ? 4 : 16);
                        const int n = y / dil, r = y % dil;
                        const int h12 = g * 4 + hs;
                        const float slope = exp2f(-8.0f * (float)(h12 + 1) / 12.0f);
                        const size_t t0 = (size_t)n * 128 * dil + r;
                        const bf16_t* qb = PROJ + pj(t0, C_SQ + h12 * 128);
                        const bf16_t* kb = PROJ + pj(0, C_SK + h12 * 128) + (ptrdiff_t)((ptrdiff_t)t0 - (ptrdiff_t)128 * dil) * PRS;
                        const bf16_t* vb = PROJ + pj(0, C_SV + h12 * 128) + (ptrdiff_t)((ptrdiff_t)t0 - (ptrdiff_t)128 * dil) * PRS;
                        bf16_t* ob = (bf16_t*)(p.ws + WS_SWAO) + ((size_t)g * S_ + t0) * 512 + hs * 128;
                        float* lb = (float*)(p.ws + WS_LSE) + ((size_t)g * S_ + t0) * 4 + hs;
                        attn_item<1, 10>(lds, qb, (size_t)dil * PRS, kb, vb, (size_t)dil * PRS, n == 0, slope * (float)dil, ob, (size_t)dil * 512, nullptr, 0, lb, (size_t)dil * 4);
                    } else {
                        const int q2 = q - 192;
                        gla_kv_item(p, lds, l, xbase + (q2 & 31) + 256 * (q2 >> 5));
                    }
                }
            }
        }
        GSYNC();
        for (int rep = 0; rep < NREP(8); ++rep) {
            const int tid = opaque_tid();
            const int wvD = __builtin_amdgcn_readfirstlane(tid >> 6);
            __syncthreads();
            if (tid == 0) *(LAS int*)(lds + 90112) = 0;
            __syncthreads();
            if (wvD < 4) {
                const bf16_t* KV = (const bf16_t*)(p.ws + WS_BIG); const float* DEC = (const float*)(p.ws + WS_DEC); bf16_t* SP = (bf16_t*)(p.ws + WS_SP);
                for (int rep2 = 0; rep2 < NREP(0x800); ++rep2) for (size_t e2 = (size_t)bx * 256 + tid; e2 < 65536; e2 += (size_t)G * 256) {
                    const int h = (int)(e2 >> 14), rest = (int)(e2 & 16383) * 2, kd = rest & 127;
                    float st0 = 0.f, st1 = 0.f;
#pragma unroll 1
                    for (int c0 = 0; c0 < 256; c0 += 32) {
                        unsigned kvv[32]; f32x2 dd[32];
#pragma unroll
                        for (int i = 0; i < 32; ++i) { const int c = c0 + i;
                            kvv[i] = *(const unsigned*)(KV + (size_t)(c * 4 + h) * 32768 + rest);
                            dd[i] = *(const f32x2*)(DEC + (c * 4 + h) * 128 + kd); }
#pragma unroll
                        for (int i = 0; i < 32; ++i) { const int c = c0 + i;
                            *(unsigned*)(SP + (size_t)(c * 4 + h) * 32768 + rest) = pk2(st0, st1);
                            st0 = dd[i].x * st0 + bflo(kvv[i]); st1 = dd[i].y * st1 + bfhi(kvv[i]); }
                    }
                }
            } else {
                const bf16_t* SO = (const bf16_t*)(p.ws + WS_SWAO); const float* LSE = (const float*)(p.ws + WS_LSE);
                for (size_t w = (size_t)bx * 256 + (tid - 256); w < (size_t)S_ * 64; w += (size_t)G * 256) {
                    const size_t t = w >> 6; const int hs = (int)(w >> 4) & 3, d8 = (int)(w & 15) * 8;
                    const float l0 = LSE[(0 * (size_t)S_ + t) * 4 + hs], l1 = LSE[(1 * (size_t)S_ + t) * 4 + hs], l2 = LSE[(2 * (size_t)S_ + t) * 4 + hs];
                    const float m = fmaxf(l0, fmaxf(l1, l2));
                    float e0 = __expf(l0 - m), e1 = __expf(l1 - m), e2 = __expf(l2 - m);
                    const float is = 1.0f / (e0 + e1 + e2); e0 *= is; e1 *= is; e2 *= is;
                    const u32x4 a = *(const u32x4*)(SO + (0 * (size_t)S_ + t) * 512 + hs * 128 + d8);
                    const u32x4 b = *(const u32x4*)(SO + (1 * (size_t)S_ + t) * 512 + hs * 128 + d8);
                    const u32x4 c = *(const u32x4*)(SO + (2 * (size_t)S_ + t) * 512 + hs * 128 + d8);
                    const u32x4 g = *(const u32x4*)(PROJ + pj(t, C_SGATE + hs * 128 + d8));
                    u32x4 o;
                    o.x = pk2((e0 * bflo(a.x) + e1 * bflo(b.x) + e2 * bflo(c.x)) * bflo(g.x), (e0 * bfhi(a.x) + e1 * bfhi(b.x) + e2 * bfhi(c.x)) * bfhi(g.x));
                    o.y = pk2((e0 * bflo(a.y) + e1 * bflo(b.y) + e2 * bflo(c.y)) * bflo(g.y), (e0 * bfhi(a.y) + e1 * bfhi(b.y) + e2 * bfhi(c.y)) * bfhi(g.y));
                    o.z = pk2((e0 * bflo(a.z) + e1 * bflo(b.z) + e2 * bflo(c.z)) * bflo(g.z), (e0 * bfhi(a.z) + e1 * bfhi(b.z) + e2 * bfhi(c.z)) * bfhi(g.z));
                    o.w = pk2((e0 * bflo(a.w) + e1 * bflo(b.w) + e2 * bflo(c.w)) * bflo(g.w), (e0 * bfhi(a.w) + e1 * bfhi(b.w) + e2 * bfhi(c.w)) * bfhi(g.w));
                    *(u32x4*)(Y + t * YW + Y_SWA + hs * 128 + d8) = o;
                }
            }
            if (l == 0) {
                LAS int* ctr = (LAS int*)(lds + 90112);
                for (;;) {
                    int idx = 0; if ((tid & 63) == 0) idx = __hip_atomic_fetch_add(ctr, 1, __ATOMIC_RELAXED, __HIP_MEMORY_SCOPE_WORKGROUP);
                    idx = __builtin_amdgcn_readfirstlane(idx);
                    const int id = bx + G * idx; if (id >= 9728) break;
                    cvt_win_item(p, 1, (LAS float*)(lds + wvD * 10240), id, tid & 63);
                }
            }
            __syncthreads();
            {
                unsigned* qhead = (unsigned*)(p.ws + WS_CTL) + 4096 + ((1 * 2 + l) * 8 + (bx & 7)) * 64;
                LAS int* sq = (LAS int*)(lds + LDS_BYTES - 32);
                const int xbase = (bx & 7) * (G / 8);
                for (;;) {
                    if (threadIdx.x == 0) *sq = (int)__hip_atomic_fetch_add(qhead, 1u, __ATOMIC_RELAXED, __HIP_MEMORY_SCOPE_AGENT);
                    lds_barrier();
                    const int q = *sq;
                    if (q >= 128) break;
                    const int q2 = q & 63, it = xbase + (q2 & 31) + 256 * (q2 >> 5);
                    if (q < 64) {
                        const int n = it >> 2, g = it & 3;
                        if (g == 0) pool_item<2>(p, lds, l, n, 0); else if (g == 1) pool_item<4>(p, lds, l, n, 1); else if (g == 2) pool_item<8>(p, lds, l, n, 2); else pool_item<16>(p, lds, l, n, 3);
                    } else {
                        const int n = it >> 2, h = it & 3;
                        const size_t t0 = (size_t)n * 128;
                        const bf16_t* mk = (const bf16_t*)(p.ws + WS_MEMKV) + (size_t)l * 256 * 1024;
                        attn_item<0, 16>(lds, PROJ + pj(t0, C_MQ + h * 128), PRS, mk + h * 128, mk + 512 + h * 128, 1024, false, 0.f,
                                     Y + t0 * YW + Y_MEM + h * 128, YW, PROJ + pj(t0, C_MGATE + h * 128), PRS, nullptr, 0);
                    }
                }
            }
        }
        GSYNC();
        {
            unsigned* qhead = (unsigned*)(p.ws + WS_CTL) + 4096 + ((2 * 2 + l) * 8 + (bx & 7)) * 64;
            LAS int* sq = (LAS int*)(lds + LDS_BYTES - 32);
            const int xbase = (bx & 7) * (G / 8);
            for (;;) {
                if (threadIdx.x == 0) *sq = (int)__hip_atomic_fetch_add(qhead, 1u, __ATOMIC_RELAXED, __HIP_MEMORY_SCOPE_AGENT);
                lds_barrier();
                const int q = *sq;
                if (q >= 128) break;
                gla_out_item(p, lds, l, xbase + (q & 31) + 256 * (q >> 5));
            }
        }
        GSYNC();
        for (int rep = 0; rep < NREP(32); ++rep) {
            __syncthreads();
            SchedMerge sch{(const char*)(p.ws + WS_Y), (const char*)(p.ws + WS_WT_BR) + (size_t)l * D_ * YW * 2, G, vcu};
            EpiMerge epi{(bf16_t*)(p.ws + WS_HREG), PROJ};
            gemm_phase(lds, YW, YW, sch, epi);
        }
        GSYNC();
        for (int rep = 0; rep < NREP(64); ++rep) {
            __syncthreads();
            SchedOut sch{(const char*)(p.ws + WS_HREG), (const char*)(p.ws + WS_WT_OUT) + (size_t)l * D_ * D_ * 2, G, vcu};
            EpiU epi{(bf16_t*)(p.ws + WS_BIG)};
            gemm_phase(lds, D_, D_, sch, epi);
        }
        GSYNC();
        __syncthreads();
        if (PH & 1024) phase_rows(p, lds, l + 1);
        if (l == 0) GSYNC();
    }
}

extern "C" void kernel_launch(void* const* d_in, const int* in_sizes, int n_in,
                              void* d_out, int out_size, void* d_ws, size_t ws_size,
                              hipStream_t stream) {
    static int grid_blocks = 0;
    if (!grid_blocks) {
        int dev = 0, cus = 0, per_cu = 0;
        hipGetDevice(&dev);
        hipDeviceGetAttribute(&cus, hipDeviceAttributeMultiprocessorCount, dev);
        hipFuncSetAttribute((const void*)fwd_megakernel, hipFuncAttributeMaxDynamicSharedMemorySize, LDS_BYTES);
        hipOccupancyMaxActiveBlocksPerMultiprocessor(&per_cu, (const void*)fwd_megakernel, NTHREADS, LDS_BYTES);
        (void)hipGetLastError();
        grid_blocks = cus;
        if (ws_size < WS_END || n_in != 18) { fprintf(stderr, "kernel_launch: workspace %zu < %zu or n_in %d != 18\n", ws_size, (size_t)WS_END, n_in); grid_blocks = -1; }
    }
    if (grid_blocks < 0) return;
    if (hipMemsetAsync((char*)d_ws + WS_CTL, 0, CTL_BYTES, stream) != hipSuccess) { fprintf(stderr, "kernel_launch: memset of the barrier words failed\n"); return; }
    Params p{};
    for (int i = 0; i < 18; ++i) p.in[i] = (const float*)d_in[i];
    p.out = (float*)d_out;
    p.ws = (unsigned char*)d_ws;
    void* args[] = {&p};
    hipError_t e = hipLaunchCooperativeKernel((const void*)fwd_megakernel, dim3(grid_blocks), dim3(NTHREADS), args, LDS_BYTES, stream);
    if (e != hipSuccess) fprintf(stderr, "cooperative launch failed: %s (grid %d)\n", hipGetErrorString(e), grid_blocks);
}
```
